# Optimizing an MI355X kernel written in HIP

```python
import jax, jax.numpy as jnp
from jax import lax
import numpy as np

D_MODEL = 1024
BATCH = 4
SEQ = 4096
DEPTH = 2

CTX_LEN = 256
GRID_W = 64
D_MIX = D_MODEL
D_SSD = D_MIX // 2
SSD_HEAD_DIM = 64
SSD_HEADS = D_SSD // SSD_HEAD_DIM
SSD_GROUPS = 2
SSD_HPG = SSD_HEADS // SSD_GROUPS
SSD_STATE = 128
SSD_CONV = 3
SSD_CHUNK = 128
D_S5 = D_MIX - D_SSD
S5_CH = 16
S5_GROUPS = D_S5 // S5_CH
S5_STATE = 64
FFN_CONV = 3
D_FF = 2816
XBC_DIM = D_SSD + 2 * SSD_GROUPS * SSD_STATE
D_PROJ = D_SSD + XBC_DIM + 2 * SSD_HEADS + D_S5
NORM_EPS = 1e-6

kernel_name = 'hybrid_bidir_ssd_s5_flow_block'


def rmsnorm(x, g):
    x32 = x.astype(jnp.float32)
    y = x32 * lax.rsqrt(jnp.mean(x32 * x32, axis=-1, keepdims=True) + NORM_EPS)
    return (y * g.astype(jnp.float32)).astype(x.dtype)


def modulate(x, shift, scale):
    return x * (1 + scale[:, None, :]) + shift[:, None, :]


def ada_params(cvec, w, b):
    return jnp.split(jax.nn.silu(cvec) @ w + b, 6, axis=-1)


def dwconv_centred(x, w, b):
    k_w = w.shape[0]
    pad = k_w // 2
    length = x.shape[1]
    xp = jnp.pad(x, ((0, 0), (pad, pad), (0, 0)))
    out = xp[:, 0:length] * w[0] + b
    for k in range(1, k_w):
        out = out + xp[:, k:k + length] * w[k]
    return out


def flip(t):
    return jnp.flip(t, axis=1)


def ssd_scan(xh, dt, a, bm, cm, h0, with_output):
    bsz, length = xh.shape[:2]
    q = SSD_CHUNK
    nc = length // q
    xh = xh.reshape(bsz, nc, q, SSD_GROUPS, SSD_HPG, SSD_HEAD_DIM)
    dt = dt.reshape(bsz, nc, q, SSD_GROUPS, SSD_HPG)
    bm = bm.reshape(bsz, nc, q, SSD_GROUPS, SSD_STATE)
    cm = cm.reshape(bsz, nc, q, SSD_GROUPS, SSD_STATE)
    cum = jnp.cumsum(dt * a.reshape(SSD_GROUPS, SSD_HPG), axis=2)
    xdt = xh * dt[..., None]
    to_end = jnp.exp(cum[:, :, -1:] - cum)
    states = jnp.einsum('bcqgn,bcqgep->bcgepn', bm, xdt * to_end[..., None])
    chunk_decay = jnp.exp(cum[:, :, -1])

    def step(h, inp):
        s, d = inp
        return h * d[..., None, None] + s, h

    h_final, h_prev = lax.scan(step, h0, (jnp.moveaxis(states, 1, 0), jnp.moveaxis(chunk_decay, 1, 0)))
    if not with_output:
        return None, h_final
    h_prev = jnp.moveaxis(h_prev, 0, 1)
    tri = jnp.tril(jnp.ones((q, q), dtype=bool))
    seg = cum[:, :, :, None] - cum[:, :, None, :]
    decay = jnp.exp(jnp.where(tri[:, :, None, None], seg, -jnp.inf))
    cb = jnp.einsum('bcign,bcjgn->bcijg', cm, bm)
    y_diag = jnp.einsum('bcijge,bcjgep->bcigep', cb[..., None] * decay, xdt)
    y_off = jnp.einsum('bcign,bcgepn->bcigep', cm, h_prev) * jnp.exp(cum)[..., None]
    y = (y_diag + y_off).reshape(bsz, length, SSD_HEADS, SSD_HEAD_DIM)
    return y, h_final


def s5_scan(bu, lam_bar, h0):
    bu = bu.at[:, 0].add(lam_bar * h0)
    a = jnp.broadcast_to(lam_bar, bu.shape)

    def combine(left, right):
        a_l, b_l = left
        a_r, b_r = right
        return a_r * a_l, a_r * b_l + b_r

    _, hs = lax.associative_scan(combine, (a, bu), axis=1)
    return hs


def token_mixers(h, p, init, with_output):
    f32 = jnp.float32
    bsz, length, _ = h.shape
    proj = h @ p['w_in']
    z, xbc, dt_raw, u = jnp.split(proj, [D_SSD, D_SSD + XBC_DIM, D_SSD + XBC_DIM + 2 * SSD_HEADS], axis=-1)

    xbc = jax.nn.silu(dwconv_centred(xbc, p['ssd_conv_w'], p['ssd_conv_b'])).astype(f32)
    xs, bm, cm = jnp.split(xbc, [D_SSD, D_SSD + SSD_GROUPS * SSD_STATE], axis=-1)
    xh = xs.reshape(bsz, length, SSD_HEADS, SSD_HEAD_DIM)
    bm = bm.reshape(bsz, length, SSD_GROUPS, SSD_STATE)
    cm = cm.reshape(bsz, length, SSD_GROUPS, SSD_STATE)
    dt = jax.nn.softplus(dt_raw.astype(f32).reshape(bsz, length, 2, SSD_HEADS) + p['ssd_dt_bias'].astype(f32))
    a = -jnp.exp(p['ssd_a_log'].astype(f32))
    h_f0, h_b0, s_f0, s_b0 = init
    y_f, hf = ssd_scan(xh, dt[:, :, 0], a[0], bm, cm, h_f0, with_output)
    y_b, hb = ssd_scan(flip(xh), flip(dt[:, :, 1]), a[1], flip(bm), flip(cm), h_b0, with_output)

    lam = lax.complex(p['s5_a_re'].astype(f32), p['s5_a_im'].astype(f32))
    step_size = jnp.exp(p['s5_log_dt'].astype(f32))[..., None]
    lam_bar = jnp.exp(lam * step_size)
    b_c = lax.complex(p['s5_b_re'].astype(f32), p['s5_b_im'].astype(f32))
    b_bar = ((lam_bar - 1) / lam)[..., None] * b_c
    ug = u.astype(f32).reshape(bsz, length, S5_GROUPS, S5_CH)
    bu_f = jnp.einsum('blgc,gpc->blgp', ug, b_bar[0])
    bu_b = jnp.einsum('blgc,gpc->blgp', flip(ug), b_bar[1])
    hs_f = s5_scan(bu_f, lam_bar[0], s_f0)
    hs_b = s5_scan(bu_b, lam_bar[1], s_b0)
    states = (hf, hb, hs_f[:, -1], hs_b[:, -1])
    if not with_output:
        return None, states

    y_ssd = y_f + flip(y_b) + xh * p['ssd_d'].astype(f32)[:, None]
    y_ssd = rmsnorm(y_ssd.reshape(bsz, length, D_SSD) * jax.nn.silu(z.astype(f32)), p['ssd_norm_g'])

    c_c = lax.complex(p['s5_c_re'].astype(f32), p['s5_c_im'].astype(f32))
    y_s5 = jnp.real(jnp.einsum('gcp,blgp->blgc', c_c, hs_f + flip(hs_b)))
    y_s5 = y_s5 + ug * p['s5_d'].astype(f32).reshape(S5_GROUPS, S5_CH)
    g = jax.nn.gelu(y_s5.reshape(bsz, length, D_S5))
    y_s5 = g * jax.nn.sigmoid(g @ p['s5_glu_w'] + p['s5_glu_b'])

    out = jnp.concatenate([y_ssd, y_s5], axis=-1).astype(h.dtype) @ p['w_out']
    return out, states


def conv_ffn(h, w_up, conv_w, conv_b, w_down, rows):
    up = h @ w_up
    bsz, length, ch = up.shape
    if rows is None:
        up = dwconv_centred(up, conv_w, conv_b)
    else:
        up = dwconv_centred(up.reshape(bsz * rows, GRID_W, ch), conv_w, conv_b).reshape(bsz, length, ch)
    gate, val = jnp.split(up, 2, axis=-1)
    return (jax.nn.silu(gate) * val) @ w_down


def setup_inputs(seed: int = 0) -> dict:
    key = jax.random.key(seed)
    ks = jax.random.split(key, 40)
    f32 = jnp.float32

    def nrm(k, shape, s):
        return jax.random.normal(k, shape, f32) * s

    dt0 = jnp.exp(jax.random.uniform(ks[12], (DEPTH, 2, SSD_HEADS), f32, np.log(1e-3), np.log(1e-1)))
    n_idx = jnp.arange(S5_STATE, dtype=f32)
    return {
        'x': nrm(ks[0], (BATCH, SEQ, D_MODEL), 1.0),
        'c': nrm(ks[1], (BATCH, D_MODEL), 1.0),
        'ctx': nrm(ks[2], (BATCH, CTX_LEN, D_MODEL), 1.0),
        'c_ctx': nrm(ks[3], (D_MODEL,), 1.0),
        'w_ada': nrm(ks[4], (DEPTH, D_MODEL, 6 * D_MODEL), D_MODEL ** -0.5),
        'b_ada': nrm(ks[5], (DEPTH, 6 * D_MODEL), 0.02),
        'g_pre_mix': 1.0 + nrm(ks[6], (DEPTH, D_MODEL), 0.05),
        'g_post_mix': 1.0 + nrm(ks[7], (DEPTH, D_MODEL), 0.05),
        'g_pre_ffn': 1.0 + nrm(ks[8], (DEPTH, D_MODEL), 0.05),
        'g_post_ffn': 1.0 + nrm(ks[9], (DEPTH, D_MODEL), 0.05),
        'w_in': nrm(ks[10], (DEPTH, D_MODEL, D_PROJ), D_MODEL ** -0.5),
        'ssd_conv_w': nrm(ks[11], (DEPTH, SSD_CONV, XBC_DIM), SSD_CONV ** -0.5),
        'ssd_conv_b': nrm(ks[13], (DEPTH, XBC_DIM), 0.02),
        'ssd_dt_bias': dt0 + jnp.log(-jnp.expm1(-dt0)),
        'ssd_a_log': jnp.log(jax.random.uniform(ks[14], (DEPTH, 2, SSD_HEADS), f32, 1.0, 16.0)),
        'ssd_d': 1.0 + nrm(ks[15], (DEPTH, SSD_HEADS), 0.05),
        'ssd_norm_g': 1.0 + nrm(ks[16], (DEPTH, D_SSD), 0.05),
        's5_a_re': -0.5 + nrm(ks[17], (DEPTH, 2, S5_GROUPS, S5_STATE), 0.01),
        's5_a_im': jnp.pi * n_idx + nrm(ks[18], (DEPTH, 2, S5_GROUPS, S5_STATE), 0.01),
        's5_log_dt': jax.random.uniform(ks[19], (DEPTH, 2, S5_GROUPS), f32, np.log(1e-3), np.log(1e-1)),
        's5_b_re': nrm(ks[20], (DEPTH, S5_GROUPS, S5_STATE, S5_CH), (2 * S5_CH) ** -0.5),
        's5_b_im': nrm(ks[21], (DEPTH, S5_GROUPS, S5_STATE, S5_CH), (2 * S5_CH) ** -0.5),
        's5_c_re': nrm(ks[22], (DEPTH, S5_GROUPS, S5_CH, S5_STATE), (2 * S5_STATE) ** -0.5),
        's5_c_im': nrm(ks[23], (DEPTH, S5_GROUPS, S5_CH, S5_STATE), (2 * S5_STATE) ** -0.5),
        's5_d': nrm(ks[24], (DEPTH, D_S5), 1.0),
        's5_glu_w': nrm(ks[25], (DEPTH, D_S5, D_S5), D_S5 ** -0.5),
        's5_glu_b': nrm(ks[26], (DEPTH, D_S5), 0.02),
        'w_out': nrm(ks[27], (DEPTH, D_MIX, D_MODEL), D_MIX ** -0.5),
        'ffn_w_up': nrm(ks[28], (DEPTH, D_MODEL, 2 * D_FF), D_MODEL ** -0.5),
        'ffn_conv_w': nrm(ks[29], (DEPTH, FFN_CONV, 2 * D_FF), FFN_CONV ** -0.5),
        'ffn_conv_b': nrm(ks[30], (DEPTH, 2 * D_FF), 0.02),
        'ffn_w_down': nrm(ks[31], (DEPTH, D_FF, D_MODEL), D_FF ** -0.5),
    }


def reference(x, c, ctx, c_ctx, w_ada, b_ada, g_pre_mix, g_post_mix, g_pre_ffn, g_post_ffn,
              w_in, ssd_conv_w, ssd_conv_b, ssd_dt_bias, ssd_a_log, ssd_d, ssd_norm_g,
              s5_a_re, s5_a_im, s5_log_dt, s5_b_re, s5_b_im, s5_c_re, s5_c_im, s5_d, s5_glu_w, s5_glu_b,
              w_out, ffn_w_up, ffn_conv_w, ffn_conv_b, ffn_w_down):
    bsz = x.shape[0]
    rows = x.shape[1] // GRID_W
    for l in range(DEPTH):
        last = l == DEPTH - 1
        p = {
            'w_in': w_in[l], 'ssd_conv_w': ssd_conv_w[l], 'ssd_conv_b': ssd_conv_b[l],
            'ssd_dt_bias': ssd_dt_bias[l], 'ssd_a_log': ssd_a_log[l], 'ssd_d': ssd_d[l],
            'ssd_norm_g': ssd_norm_g[l], 's5_a_re': s5_a_re[l], 's5_a_im': s5_a_im[l],
            's5_log_dt': s5_log_dt[l], 's5_b_re': s5_b_re[l], 's5_b_im': s5_b_im[l],
            's5_c_re': s5_c_re[l], 's5_c_im': s5_c_im[l], 's5_d': s5_d[l],
            's5_glu_w': s5_glu_w[l], 's5_glu_b': s5_glu_b[l], 'w_out': w_out[l],
        }
        sh1, sc1, gt1, sh2, sc2, gt2 = ada_params(c, w_ada[l], b_ada[l])
        csh1, csc1, cgt1, csh2, csc2, cgt2 = ada_params(c_ctx[None, :], w_ada[l], b_ada[l])
        zero_states = (
            jnp.zeros((bsz, SSD_GROUPS, SSD_HPG, SSD_HEAD_DIM, SSD_STATE), jnp.float32),
            jnp.zeros((bsz, SSD_GROUPS, SSD_HPG, SSD_HEAD_DIM, SSD_STATE), jnp.float32),
            jnp.zeros((bsz, S5_GROUPS, S5_STATE), jnp.complex64),
            jnp.zeros((bsz, S5_GROUPS, S5_STATE), jnp.complex64),
        )
        hc = modulate(rmsnorm(ctx, g_pre_mix[l]), csh1, csc1)
        ctx_mix, ctx_states = token_mixers(hc, p, zero_states, not last)
        hx = modulate(rmsnorm(x, g_pre_mix[l]), sh1, sc1)
        x_mix, _ = token_mixers(hx, p, ctx_states, True)
        x = x + gt1[:, None, :] * rmsnorm(x_mix, g_post_mix[l])
        hx = modulate(rmsnorm(x, g_pre_ffn[l]), sh2, sc2)
        x = x + gt2[:, None, :] * rmsnorm(conv_ffn(hx, ffn_w_up[l], ffn_conv_w[l], ffn_conv_b[l], ffn_w_down[l], rows), g_post_ffn[l])
        if not last:
            ctx = ctx + cgt1[:, None, :] * rmsnorm(ctx_mix, g_post_mix[l])
            hc = modulate(rmsnorm(ctx, g_pre_ffn[l]), csh2, csc2)
            ctx = ctx + cgt2[:, None, :] * rmsnorm(conv_ffn(hc, ffn_w_up[l], ffn_conv_w[l], ffn_conv_b[l], ffn_w_down[l], None), g_post_ffn[l])
    return x
```

```cpp
#include <hip/hip_runtime.h>
#include <cstdio>
#include <cstdint>
namespace pg8 {
#define PG8_LAS __attribute__((address_space(3)))
typedef unsigned short bf16_t;
typedef short bf16x8 __attribute__((ext_vector_type(8)));
typedef float f32x4 __attribute__((ext_vector_type(4)));
typedef unsigned u32x4 __attribute__((ext_vector_type(4)));
constexpr int BM = 256, BK = 64, HALF = 128, HTB = HALF * BK * 2  , STAGE_BYTES = 8 * HTB, NXCD = 8, WGM = 8;

__host__ __device__ __forceinline__ int lds_byte(int r, int c) { const int st = (r >> 4) * 2 + (c >> 5), rr = r & 15, cc = c & 31, ob = rr * 64 + cc * 2; return st * 1024 + (ob ^ (((ob >> 9) & 1) << 5)); }
__host__ __device__ __forceinline__ void stage_rc(int b, int& R, int& C) { const int st = b / 1024, sb = b % 1024, swz = sb ^ (((sb >> 9) & 1) << 5); R = (st >> 1) * 16 + swz / 64; C = (st & 1) * 32 + (swz % 64) / 2; }
__host__ __device__ __forceinline__ int perm32(int rho) { const int n = rho >> 4, i = rho & 15; return 8 * (i >> 2) + 4 * n + (i & 3); }

struct Unit { int pm, pn; };
struct Gemm { const bf16_t* A; const bf16_t* Bt; int M, N, K; };

struct StaticOrder {
    int nM, nN, nwg, G, c;
    __host__ __device__ void init(int M, int N, int G_, int c_) { nM = M / BM; nN = N / BM; nwg = nM * nN; G = G_; c = c_; }
    __host__ __device__ bool next(int i, Unit& u) const {
        const long L = (long)i * G + c; if (L >= nwg) return false;
        int wgid = (int)L; { const int q = nwg / NXCD, r = nwg % NXCD, xcd = wgid % NXCD, off = wgid / NXCD; wgid = (xcd < r ? xcd * (q + 1) : r * (q + 1) + (xcd - r) * q) + off; }
        const int nig = WGM * nN, gid = wgid / nig, fm = gid * WGM, gsz = (nM - fm) < WGM ? (nM - fm) : WGM;
        u.pm = fm + ((wgid % nig) % gsz); u.pn = (wgid % nig) / gsz; return true;
    }
    __device__ __forceinline__ void a_ready(const Unit&) const {}
    __device__ __forceinline__ void done(const Unit&) const {}
};

__device__ __forceinline__ unsigned cvt_pk_bf16(float lo, float hi) { unsigned r; asm volatile("v_cvt_pk_bf16_f32 %0, %1, %2" : "=v"(r) : "v"(lo), "v"(hi)); return r; }
__device__ __forceinline__ float bf_lo(unsigned w) { return __uint_as_float(w << 16); }
__device__ __forceinline__ float bf_hi(unsigned w) { return __uint_as_float(w & 0xffff0000u); }
__device__ __forceinline__ float sigmoidf_(float x) { return 1.0f / (1.0f + __expf(-x)); }

struct EpiStoreBf16 {
    static constexpr bool PERM = true, AFTER_DRAIN = false;
    bf16_t* O; int ldc;
    __device__ __forceinline__ void operator()(const f32x4 (&acc)[2][2][4][2], const Unit& u, int wr, int wc, int fr, int fq) const {
        const int row0 = u.pm * BM + wr * 64 + fr, col0 = u.pn * BM + wc * 32 + 8 * fq;
#pragma unroll
        for (int ai = 0; ai < 2; ++ai)
#pragma unroll
            for (int m = 0; m < 4; ++m) { bf16_t* rowp = O + (size_t)(row0 + ai * HALF + m * 16) * ldc + col0;
#pragma unroll
                for (int bj = 0; bj < 2; ++bj) { const f32x4 v0 = acc[ai][bj][m][0], v1 = acc[ai][bj][m][1];
                    u32x4 w; w.x = cvt_pk_bf16(v0[0], v0[1]); w.y = cvt_pk_bf16(v0[2], v0[3]); w.z = cvt_pk_bf16(v1[0], v1[1]); w.w = cvt_pk_bf16(v1[2], v1[3]);
                    *(u32x4*)(rowp + bj * HALF) = w; } }
    }
};
struct EpiStoreF32 {
    static constexpr bool PERM = false, AFTER_DRAIN = false;
    float* C; int ldc;
    __device__ __forceinline__ void operator()(const f32x4 (&acc)[2][2][4][2], const Unit& u, int wr, int wc, int fr, int fq) const {
        const int row0 = u.pm * BM + wr * 64 + fr, col0 = u.pn * BM + wc * 32 + 4 * fq;
#pragma unroll
        for (int ai = 0; ai < 2; ++ai)
#pragma unroll
            for (int m = 0; m < 4; ++m) { float* rowp = C + (size_t)(row0 + ai * HALF + m * 16) * ldc + col0;
#pragma unroll
                for (int bj = 0; bj < 2; ++bj)
#pragma unroll
                    for (int n = 0; n < 2; ++n) *(f32x4*)(rowp + bj * HALF + n * 16) = acc[ai][bj][m][n]; }
    }
};
struct EpiGlu {
    static constexpr bool PERM = true, AFTER_DRAIN = false;
    const bf16_t* Gm; bf16_t* O; const float* bias;
    __device__ __forceinline__ void operator()(const f32x4 (&acc)[2][2][4][2], const Unit& u, int wr, int wc, int fr, int fq) const {
        const int row0 = u.pm * BM + wr * 64 + fr, col0 = u.pn * BM + wc * 32 + 8 * fq;
#pragma unroll
        for (int ai = 0; ai < 2; ++ai)
#pragma unroll
            for (int m = 0; m < 4; ++m) { const int r = row0 + ai * HALF + m * 16;
#pragma unroll
                for (int bj = 0; bj < 2; ++bj) { const int c = col0 + bj * HALF;
                    const u32x4 gv = *(const u32x4*)(Gm + (size_t)r * 512 + c);
                    const f32x4 b0 = *(const f32x4*)(bias + c), b1 = *(const f32x4*)(bias + c + 4);
                    const f32x4 v0 = acc[ai][bj][m][0] + b0, v1 = acc[ai][bj][m][1] + b1;
                    u32x4 w;
                    w.x = cvt_pk_bf16(bf_lo(gv.x) * sigmoidf_(v0[0]), bf_hi(gv.x) * sigmoidf_(v0[1]));
                    w.y = cvt_pk_bf16(bf_lo(gv.y) * sigmoidf_(v0[2]), bf_hi(gv.y) * sigmoidf_(v0[3]));
                    w.z = cvt_pk_bf16(bf_lo(gv.z) * sigmoidf_(v1[0]), bf_hi(gv.z) * sigmoidf_(v1[1]));
                    w.w = cvt_pk_bf16(bf_lo(gv.w) * sigmoidf_(v1[2]), bf_hi(gv.w) * sigmoidf_(v1[3]));
                    *(u32x4*)(O + (size_t)r * 1024 + c) = w; } }
    }
};
#ifndef FFN_USE_SHFL
__device__ __forceinline__ float dpp_prev(float cur, float below  , bool has_below) {
    const int old = has_below ? __builtin_amdgcn_update_dpp(0, __builtin_bit_cast(int, below), 0x121, 0xf, 0xf, false) : 0;
    return __builtin_bit_cast(float, __builtin_amdgcn_update_dpp(old, __builtin_bit_cast(int, cur), 0x111, 0xf, 0xf, false));
}
__device__ __forceinline__ float dpp_next(float cur, float above, bool has_above) {
    const int old = has_above ? __builtin_amdgcn_update_dpp(0, __builtin_bit_cast(int, above), 0x12F, 0xf, 0xf, false) : 0;
    return __builtin_bit_cast(float, __builtin_amdgcn_update_dpp(old, __builtin_bit_cast(int, cur), 0x101, 0xf, 0xf, false));
}
#endif
struct EpiFfnUp {
    static constexpr bool PERM = true, AFTER_DRAIN = false;
    bf16_t* H; const float* cw; const float* cb; int tile0;
    __device__ __forceinline__ void operator()(const f32x4 (&acc)[2][2][4][2], const Unit& u, int wr, int wc, int fr, int fq) const {
        typedef unsigned u32x2 __attribute__((ext_vector_type(2)));
        const int ch0 = u.pn * 128 + wc * 32 + 8 * fq;
#ifdef FFN_USE_SHFL
        const int lane = fr + 16 * fq;
        const int lm1 = (lane + 63) & 63, lp15 = (lane + 15) & 63, lp1 = (lane + 1) & 63, lm15 = (lane + 49) & 63;
#endif
        const int T = tile0 + u.pm;
        const bool isctx = T < 5;
#pragma unroll
        for (int n = 0; n < 2; ++n) {
            f32x4 w0[2], w1[2], w2[2], bb[2];
#pragma unroll
            for (int h = 0; h < 2; ++h) { const int col = h * 2816 + ch0 + 4 * n;
                w0[h] = *(const f32x4*)(cw + col); w1[h] = *(const f32x4*)(cw + 5632 + col); w2[h] = *(const f32x4*)(cw + 2 * 5632 + col); bb[h] = *(const f32x4*)(cb + col); }
#pragma unroll
            for (int ai = 0; ai < 2; ++ai) {
                const int B = T * 4 + ai * 2 + wr;
                int orow0, tok0 = 0;
                if (isctx) { const int b = B / 5, blk = B - 5 * b; tok0 = 62 * blk - 1; orow0 = b * 256 + tok0; }
                else orow0 = 1024 + (T - 5) * 256 + ai * 128 + wr * 64;
#pragma unroll
                for (int m = 0; m < 4; ++m) {
                    f32x4 cv[2];
#pragma unroll
                    for (int h = 0; h < 2; ++h) {
                        f32x4 o;
#pragma unroll
                        for (int j = 0; j < 4; ++j) {
                            const float cur = acc[ai][h][m][n][j];
#ifdef FFN_USE_SHFL
                            const float pa = __shfl(cur, lm1);
                            const float pb = (m > 0) ? __shfl(acc[ai][h][m > 0 ? m - 1 : 0][n][j], lp15) : 0.f;
                            const float na = __shfl(cur, lp1);
                            const float nb = (m < 3) ? __shfl(acc[ai][h][m < 3 ? m + 1 : 3][n][j], lm15) : 0.f;
                            const float prev = fr > 0 ? pa : pb, next = fr < 15 ? na : nb;
#else
                            const float prev = dpp_prev(cur, acc[ai][h][m > 0 ? m - 1 : 0][n][j], m > 0);
                            const float next = dpp_next(cur, acc[ai][h][m < 3 ? m + 1 : 3][n][j], m < 3);
#endif
                            o[j] = bb[h][j] + w0[h][j] * prev + w1[h][j] * cur + w2[h][j] * next;
                        }
                        cv[h] = o;
                    }
                    const int i = 16 * m + fr;
                    bool valid = true;
                    if (isctx) valid = (i >= 1) && (i <= 62) && (tok0 + i < 256);
                    float o[4];
#pragma unroll
                    for (int j = 0; j < 4; ++j) { const float g = cv[0][j], v = cv[1][j]; o[j] = g * sigmoidf_(g) * v; }
                    u32x2 w; w.x = cvt_pk_bf16(o[0], o[1]); w.y = cvt_pk_bf16(o[2], o[3]);
                    if (valid) *(u32x2*)(H + (size_t)(orow0 + i) * 2816 + ch0 + 4 * n) = w;
                }
            }
        }
    }
};

template <class Epi, class Sched, bool ALIGN_EPI = false, bool SP2 = false>
__device__ __forceinline__ void gemm_phase(PG8_LAS unsigned char* lds, const Gemm g, const Sched& S, const Epi& E, const int tid_in) {
    const int tid = tid_in, wid = __builtin_amdgcn_readfirstlane(tid >> 6), lane = tid & 63, wr = wid >> 2, wc = wid & 3, fr = lane & 15, fq = lane >> 4;
    const int K = g.K, nt = K / BK;
    unsigned voffA[2], voffB[2];
#pragma unroll
    for (int i = 0; i < 2; ++i) { int R, C; stage_rc(tid * 16 + i * 8192, R, C); const int Rb = Epi::PERM ? ((R & ~31) + perm32(R & 31)) : R;
        voffA[i] = (unsigned)(R * K + C) * 2u; voffB[i] = (unsigned)(Rb * K + C) * 2u; }
    const size_t kstep = (size_t)(BK * 2);
    const size_t hstep = (size_t)HALF * K * 2;
    const size_t tstep = 2 * hstep;
    const unsigned ldsw = (unsigned)wid * 1024u;
    const int aoff = lds_byte(wr * 64 + fr, fq * 8), boff = lds_byte(wc * 32 + fr, fq * 8);
#define PG8_SA(b, h) (((b) * 2 + (h)) * HTB)
#define PG8_SB(b, h) ((4 + (b) * 2 + (h)) * HTB)
#define PG8_STAGE(bufoff, gbase, voff) do { _Pragma("unroll") for (int _i = 0; _i < 2; ++_i) \
        __builtin_amdgcn_global_load_lds((const unsigned*)((const char*)(gbase) + (voff)[_i]), (PG8_LAS unsigned*)(lds + (bufoff) + ldsw + _i * 8192), 16, 0, 0); } while (0)
#define PG8_LDA(dst, b, h) do { _Pragma("unroll") for (int m = 0; m < 4; ++m) _Pragma("unroll") for (int k = 0; k < 2; ++k) dst[m][k] = *(const PG8_LAS bf16x8*)(lds + PG8_SA(b, h) + aoff + m * 2048 + k * 1024); } while (0)
#define PG8_LDB(dst, b, h) do { _Pragma("unroll") for (int n = 0; n < 2; ++n) _Pragma("unroll") for (int k = 0; k < 2; ++k) dst[n][k] = *(const PG8_LAS bf16x8*)(lds + PG8_SB(b, h) + boff + n * 2048 + k * 1024); } while (0)
#define PG8_MMA(ai, bj, At, Bt) do { __builtin_amdgcn_s_setprio(1); _Pragma("unroll") for (int m = 0; m < 4; ++m) _Pragma("unroll") for (int n = 0; n < 2; ++n) _Pragma("unroll") for (int k = 0; k < 2; ++k) \
        acc[ai][bj][m][n] = __builtin_amdgcn_mfma_f32_16x16x32_bf16(Bt[n][k], At[m][k], acc[ai][bj][m][n], 0, 0, 0); __builtin_amdgcn_s_setprio(0); } while (0)
#define PG8_WAIT_V(n) asm volatile("s_waitcnt vmcnt(" #n ")" ::: "memory")
#define PG8_WAIT_L(n) asm volatile("s_waitcnt lgkmcnt(" #n ")" ::: "memory")
#define PG8_BAR __builtin_amdgcn_s_barrier()
#define PG8_SCHED __builtin_amdgcn_sched_barrier(0)
    Unit cur, nxt; int ui = 0;
    if (!S.next(0, cur)) return;
    f32x4 acc[2][2][4][2];
#pragma unroll
    for (int a = 0; a < 2; ++a)
#pragma unroll
        for (int b = 0; b < 2; ++b)
#pragma unroll
            for (int m = 0; m < 4; ++m)
#pragma unroll
                for (int n = 0; n < 2; ++n) acc[a][b][m][n] = (f32x4){0.f, 0.f, 0.f, 0.f};
    bf16x8 At[4][2], B0[2][2], B1[2][2];
    const char* cA = (const char*)g.A + (size_t)cur.pm * tstep; const char* cB = (const char*)g.Bt + (size_t)cur.pn * tstep;
    S.a_ready(cur);
    if constexpr (SP2) {
        PG8_STAGE(PG8_SB(0, 0), cB, voffB); PG8_STAGE(PG8_SB(0, 1), cB + hstep, voffB); PG8_STAGE(PG8_SA(0, 0), cA, voffA); PG8_STAGE(PG8_SA(0, 1), cA + hstep, voffA);
        if (wr == 1) PG8_BAR;
        PG8_WAIT_V(2); PG8_BAR;
        PG8_STAGE(PG8_SB(1, 0), cB + kstep, voffB); PG8_STAGE(PG8_SA(1, 0), cA + kstep, voffA); PG8_STAGE(PG8_SB(1, 1), cB + hstep + kstep, voffB);
        PG8_WAIT_V(6); PG8_BAR;
    } else {
        PG8_STAGE(PG8_SB(0, 0), cB, voffB); PG8_STAGE(PG8_SA(0, 0), cA, voffA); PG8_STAGE(PG8_SB(0, 1), cB + hstep, voffB); PG8_STAGE(PG8_SA(0, 1), cA + hstep, voffA);
        if (wr == 1) PG8_BAR;
        PG8_WAIT_V(4); PG8_BAR;
        PG8_STAGE(PG8_SB(1, 0), cB + kstep, voffB); PG8_STAGE(PG8_SA(1, 0), cA + kstep, voffA); PG8_STAGE(PG8_SB(1, 1), cB + hstep + kstep, voffB);
        PG8_WAIT_V(6); PG8_BAR;
    }
    for (;;) {
        const bool has_next = S.next(ui + 1, nxt);
        const char* nA = has_next ? (const char*)g.A + (size_t)nxt.pm * tstep : cA; const char* nB = has_next ? (const char*)g.Bt + (size_t)nxt.pn * tstep : cB;
        for (int t = 0; t < nt; t += 2) {
            const bool last = (t == nt - 2);
            const char* a1 = cA + (size_t)(t + 1) * kstep;
            const char* a2 = last ? nA : cA + (size_t)(t + 2) * kstep; const char* b2 = last ? nB : cB + (size_t)(t + 2) * kstep;
            const char* a3 = a2 + kstep; const char* b3 = b2 + kstep;
            if (last && has_next) S.a_ready(nxt);
            if constexpr (SP2) {
            PG8_LDB(B0, 0, 0); PG8_LDB(B1, 0, 1); PG8_SCHED; PG8_LDA(At, 0, 0); PG8_STAGE(PG8_SA(1, 1), a1 + hstep, voffA);
            PG8_WAIT_V(8); PG8_WAIT_L(0); PG8_BAR; PG8_MMA(0, 0, At, B0); PG8_MMA(0, 1, At, B1); PG8_BAR; PG8_SCHED;
            PG8_LDA(At, 0, 1); PG8_STAGE(PG8_SB(0, 0), b2, voffB); PG8_STAGE(PG8_SB(0, 1), b2 + hstep, voffB); PG8_STAGE(PG8_SA(0, 0), a2, voffA);
            PG8_WAIT_V(8); PG8_WAIT_L(0); PG8_BAR; PG8_MMA(1, 0, At, B0); PG8_MMA(1, 1, At, B1); PG8_BAR; PG8_SCHED;
            PG8_LDB(B0, 1, 0); PG8_LDB(B1, 1, 1); PG8_SCHED; PG8_LDA(At, 1, 0); PG8_STAGE(PG8_SA(0, 1), a2 + hstep, voffA);
            PG8_WAIT_V(8); PG8_WAIT_L(0); PG8_BAR; PG8_MMA(0, 0, At, B0); PG8_MMA(0, 1, At, B1); PG8_BAR; PG8_SCHED;
            PG8_LDA(At, 1, 1); PG8_STAGE(PG8_SB(1, 0), b3, voffB); PG8_STAGE(PG8_SB(1, 1), b3 + hstep, voffB); PG8_STAGE(PG8_SA(1, 0), a3, voffA);
            PG8_WAIT_V(8); PG8_WAIT_L(0); PG8_BAR; PG8_MMA(1, 0, At, B0); PG8_MMA(1, 1, At, B1); PG8_BAR; PG8_SCHED;
            } else {
            PG8_LDB(B0, 0, 0); PG8_SCHED; PG8_LDA(At, 0, 0); PG8_STAGE(PG8_SA(1, 1), a1 + hstep, voffA);
            PG8_WAIT_L(8); PG8_BAR; PG8_WAIT_L(0); PG8_MMA(0, 0, At, B0); PG8_BAR; PG8_SCHED;
            PG8_LDB(B1, 0, 1); PG8_STAGE(PG8_SB(0, 0), b2, voffB);
            PG8_BAR; PG8_WAIT_L(0); PG8_MMA(0, 1, At, B1); PG8_BAR;
            PG8_LDA(At, 0, 1); PG8_STAGE(PG8_SA(0, 0), a2, voffA);
            PG8_BAR; PG8_WAIT_L(0); PG8_MMA(1, 0, At, B0); PG8_BAR; PG8_SCHED;
            PG8_STAGE(PG8_SB(0, 1), b2 + hstep, voffB);
            PG8_WAIT_V(6); PG8_BAR; PG8_MMA(1, 1, At, B1); PG8_BAR;
            PG8_LDB(B0, 1, 0); PG8_SCHED; PG8_LDA(At, 1, 0); PG8_STAGE(PG8_SA(0, 1), a2 + hstep, voffA);
            PG8_WAIT_L(8); PG8_BAR; PG8_WAIT_L(0); PG8_MMA(0, 0, At, B0); PG8_BAR; PG8_SCHED;
            PG8_LDB(B1, 1, 1); PG8_STAGE(PG8_SB(1, 0), b3, voffB);
            PG8_BAR; PG8_WAIT_L(0); PG8_MMA(0, 1, At, B1); PG8_BAR;
            PG8_LDA(At, 1, 1); PG8_STAGE(PG8_SA(1, 0), a3, voffA);
            PG8_BAR; PG8_WAIT_L(0); PG8_MMA(1, 0, At, B0); PG8_BAR; PG8_SCHED;
            PG8_STAGE(PG8_SB(1, 1), b3 + hstep, voffB);
            PG8_WAIT_V(6); PG8_BAR; PG8_MMA(1, 1, At, B1); PG8_BAR;
            }
        }
        if constexpr (ALIGN_EPI) { if (wr == 0) PG8_BAR; }
        if constexpr (!Epi::AFTER_DRAIN) { E(acc, cur, wr, wc, fr, fq); S.done(cur); }
        if (!has_next) break;
#pragma unroll
        for (int a = 0; a < 2; ++a)
#pragma unroll
            for (int b = 0; b < 2; ++b)
#pragma unroll
                for (int m = 0; m < 4; ++m)
#pragma unroll
                    for (int n = 0; n < 2; ++n) acc[a][b][m][n] = (f32x4){0.f, 0.f, 0.f, 0.f};
        cur = nxt; cA = nA; cB = nB; ++ui;
        if constexpr (ALIGN_EPI) { if (wr == 1) PG8_BAR; }
    }
    PG8_WAIT_V(0);
    if constexpr (!ALIGN_EPI) { if (wr == 0) PG8_BAR; }
    PG8_BAR;
    if constexpr (Epi::AFTER_DRAIN) { E.fused(acc, cur, wr, wc, fr, fq, lds, wid, lane); S.done(cur); }
#undef PG8_SA
#undef PG8_SB
#undef PG8_STAGE
#undef PG8_LDA
#undef PG8_LDB
#undef PG8_MMA
#undef PG8_WAIT_V
#undef PG8_WAIT_L
#undef PG8_BAR
#undef PG8_SCHED
}
}
constexpr int NWAVES = 8, NTHR = 512;
constexpr int DM = 1024, NB = 4, SEQ = 4096, CTXL = 256, DEPTH = 2;
constexpr int RC = NB * CTXL, RL = NB * SEQ, RT = RC + RL;
constexpr int RH = 1280 + RL;
constexpr int DSSD = 512, NHEAD = 8, HD = 64, NGRP = 2, HPG = 4, NST = 128, QCH = 128;
constexpr int DS5 = 512, S5C = 16, S5G = 32, S5P = 64;
constexpr int DFF = 2816, XBC = 1024, DPROJ = 2064, NZXU = 2048;
constexpr int NSLOT = 34, NSLOT5 = 68;
constexpr float EPS = 1e-6f;
enum { I_X = 0, I_C, I_CTX, I_CCTX, I_WADA, I_BADA, I_GPREMIX, I_GPOSTMIX, I_GPREFFN, I_GPOSTFFN, I_WIN, I_SCONVW, I_SCONVB, I_DTBIAS, I_ALOG, I_SSDD, I_SNORMG,
       I_ARE, I_AIM, I_LOGDT, I_BRE, I_BIM, I_CRE, I_CIM, I_S5D, I_GLUW, I_GLUB, I_WOUT, I_WUP, I_FCONVW, I_FCONVB, I_WDOWN, N_IN };
constexpr size_t KiB = 1024, MiB = 1u << 20;
constexpr size_t WS_CTL = 0, CTL_ZERO_BYTES = 64 * KiB;
constexpr size_t WS_ADA = 1 * MiB;
constexpr size_t WS_LAMB = 1 * MiB + 512 * KiB;
constexpr size_t WS_LAMQ = WS_LAMB + 64 * KiB;
constexpr size_t WS_CMAT = WS_LAMQ + 64 * KiB;
constexpr size_t WS_BBAR = 2 * MiB;
constexpr size_t WS_DT = 4 * MiB;
constexpr size_t WS_SSQ = 5 * MiB + 512 * KiB;
constexpr size_t WS_DEC = 5 * MiB + 768 * KiB;
constexpr size_t WS_S5ST = 6 * MiB;
constexpr size_t WS_CTXX = 15 * MiB;
constexpr size_t WS_WIN = 19 * MiB, WS_WGLU = 23 * MiB, WS_WOUT = 23 * MiB + 512 * KiB, WS_WUP = 25 * MiB + 512 * KiB, WS_WDOWN = 36 * MiB + 512 * KiB;
constexpr size_t WS_A = 42 * MiB;
constexpr size_t WS_MIX = 110 * MiB;
constexpr size_t WS_G = 144 * MiB;
constexpr size_t WS_ZXU = 161 * MiB;
constexpr size_t WS_HACT = 80 * MiB;
constexpr size_t WS_FOUT = 174 * MiB;
constexpr size_t WS_END = 242 * MiB;
constexpr int CW_BAR = 4096;
constexpr int RING_BYTES = 131072;
constexpr int LDS_BYTES = 163840;
constexpr int LDSCTL_OFF = LDS_BYTES - 1024, MISC_OFF = LDSCTL_OFF + 320, PTAB_OFF = LDSCTL_OFF + 512;

#define GAS __attribute__((address_space(1)))
#define LAS __attribute__((address_space(3)))
typedef unsigned short bf16;
typedef unsigned v4u __attribute__((ext_vector_type(4)));
typedef unsigned v2u __attribute__((ext_vector_type(2)));
typedef float f32x4 __attribute__((ext_vector_type(4)));
typedef float f32x2 __attribute__((ext_vector_type(2)));
typedef short bf16x8 __attribute__((ext_vector_type(8)));
typedef GAS unsigned gu32;
#define RLX_AGENT __ATOMIC_RELAXED, __HIP_MEMORY_SCOPE_AGENT
#define LDS_WAIT() asm volatile("s_waitcnt lgkmcnt(0)" ::: "memory")
__device__ __forceinline__ unsigned f2bf(float f) { unsigned u = __builtin_bit_cast(unsigned, f); return (u + 0x7fffu + ((u >> 16) & 1u)) >> 16; }
__device__ __forceinline__ unsigned pk2(float lo, float hi) { return f2bf(lo) | (f2bf(hi) << 16); }
__device__ __forceinline__ float bf2f(unsigned h) { return __uint_as_float(h << 16); }
__device__ __forceinline__ float bflo(unsigned w) { return __uint_as_float(w << 16); }
__device__ __forceinline__ float bfhi(unsigned w) { return __uint_as_float(w & 0xffff0000u); }
__device__ __forceinline__ float siluf_(float x) { return x / (1.0f + __expf(-x)); }
#define XB_TMO      128
#define XB_XCNT(j)  (256  + 64 * (j))
#define XB_XSUB(j)  (1280 + 64 * (j))
#define XB_XGEN(j)  (2304 + 64 * (j))
#define XB_TOP      3328
#define XB_TOPGEN   3392
#define XCD_BAR_WORDS 3456
#define XB_SPIN_CAP (1u << 18)

__device__ __forceinline__ unsigned xb_ld(unsigned* p)              { return __hip_atomic_load(p, __ATOMIC_RELAXED, __HIP_MEMORY_SCOPE_AGENT); }
__device__ __forceinline__ unsigned xb_add(unsigned* p, unsigned v) { return __hip_atomic_fetch_add(p, v, __ATOMIC_RELAXED, __HIP_MEMORY_SCOPE_AGENT); }
__device__ __forceinline__ unsigned xb_xcc_id() { return (unsigned)__builtin_amdgcn_s_getreg((3 << 11) | 20) & 0xFu; }
#define XB_SPIN(cond, bar) do { unsigned _sp = 0; while (cond) { __builtin_amdgcn_s_sleep(1); \
    if ((++_sp & 255u) == 0u) { if (xb_ld(&(bar)[XB_TMO])) break; if (_sp > XB_SPIN_CAP) { atomicAdd(&(bar)[XB_TMO], 1u); break; } } } } while (0)

struct XcdBarrier {
    unsigned* bar; unsigned x;
    volatile LAS unsigned* st;
};

__device__ __forceinline__ XcdBarrier xcd_barrier_post(unsigned* bar, volatile LAS unsigned* st) {
    XcdBarrier b; b.bar = bar; b.x = xb_xcc_id(); b.st = st;
    if (threadIdx.x == 0) (void)xb_add(&bar[XB_XCNT(b.x)], 1u);
    return b;
}
__device__ __forceinline__ void xcd_barrier_complete(unsigned* bar, unsigned x, unsigned& nloc, unsigned& nx) {
    const unsigned G = gridDim.x * gridDim.y * gridDim.z;
    unsigned sum, cnt, mine, sp = 0u;
    for (;;) {
        sum = 0u; cnt = 0u; mine = 0u;
#pragma unroll
        for (unsigned j = 0; j < 16; ++j) { const unsigned c = xb_ld(&bar[XB_XCNT(j)]); sum += c; cnt += (c > 0u) ? 1u : 0u; mine = (j == x) ? c : mine; }
        if (sum == G) break;
        __builtin_amdgcn_s_sleep(1);
        if ((++sp & 255u) == 0u) { if (xb_ld(&bar[XB_TMO])) break; if (sp > XB_SPIN_CAP) { atomicAdd(&bar[XB_TMO], 1u); break; } }
    }
    nloc = mine > 0u ? mine : 1u; nx = cnt > 0u ? cnt : 1u;
}

__device__ __forceinline__ void xcd_barrier(const XcdBarrier& b) {
    asm volatile("s_waitcnt vmcnt(0)" ::: "memory");
    __syncthreads();
    if (threadIdx.x == 0) {
        unsigned* bar = b.bar;
        __builtin_amdgcn_s_waitcnt(0);
        unsigned nloc = b.st[0], nx = b.st[1];
        if (nloc == 0u) { xcd_barrier_complete(bar, b.x, nloc, nx); b.st[0] = nloc; b.st[1] = nx; }
        const unsigned old = xb_add(&bar[XB_XSUB(b.x)], 1u);
        const unsigned gen = old / nloc;
        if (old + 1u == (gen + 1u) * nloc) {
            __builtin_amdgcn_fence(__ATOMIC_RELEASE, "agent");
            asm volatile("s_waitcnt vmcnt(0)" ::: "memory");
            const unsigned og = xb_add(&bar[XB_TOP], 1u);
            const unsigned tg = og / nx;
            if (og + 1u == (tg + 1u) * nx) xb_add(&bar[XB_TOPGEN], 1u);
            else XB_SPIN(xb_ld(&bar[XB_TOPGEN]) == tg, bar);
            __builtin_amdgcn_fence(__ATOMIC_ACQUIRE, "agent");
            xb_add(&bar[XB_XGEN(b.x)], 1u);
            asm volatile("s_waitcnt vmcnt(0)" ::: "memory");
        } else {
            XB_SPIN(xb_ld(&bar[XB_XGEN(b.x)]) == gen, bar);
            __builtin_amdgcn_fence(__ATOMIC_ACQUIRE, "agent");
            asm volatile("s_waitcnt vmcnt(0)" ::: "memory");
        }
    }
    __syncthreads();
}
struct Frame {
    LAS unsigned char* lds;
    volatile LAS unsigned* MISC;
    gu32* ctl;
    int tid, lane, wave;
    int vcu, G;
    const LAS unsigned long long* ptab;
    float* out;
    unsigned char* ws;
};
#define INP(i) ((const float*)(GAS const float*)F.ptab[(i)])
__device__ __forceinline__ float wave_sum(float v) {
#pragma unroll
    for (int o = 1; o < 64; o <<= 1) v += __shfl_xor(v, o);
    return v;
}
__device__ __forceinline__ int row_batch(int r) { return r < RC ? (r >> 8) : ((r - RC) >> 12); }
__device__ __forceinline__ int row_modv(int r) { return r < RC ? 4 : ((r - RC) >> 12); }

__device__ __forceinline__ void p0_ada_tables(Frame& F) {
    LAS float* sc = (LAS float*)(F.lds);
    LAS float* red = sc + 5 * 1024;
    const float* cv = INP(I_C); const float* cc = INP(I_CCTX);
    for (int i = F.tid; i < 5120; i += NTHR) { const int v = i >> 10, k = i & 1023; const float c = v < 4 ? cv[v * 1024 + k] : cc[k]; sc[i] = c / (1.0f + expf(-c)); }
    __syncthreads();
    float* ada = (float*)(F.ws + WS_ADA);
    const float* wada = INP(I_WADA); const float* bada = INP(I_BADA);
    for (int unit = F.vcu; unit < 384; unit += F.G) {
        const int l = unit / 192, j0 = (unit % 192) * 32, col = F.tid & 31, kq = F.tid >> 5;
        float acc[5] = {0.f, 0.f, 0.f, 0.f, 0.f};
        const float* w = wada + (size_t)l * 1024 * 6144 + j0 + col;
#pragma unroll 8
        for (int k = kq; k < 1024; k += 16) { const float wv = w[(size_t)k * 6144];
#pragma unroll
            for (int v = 0; v < 5; ++v) acc[v] += sc[v * 1024 + k] * wv; }
#pragma unroll
        for (int v = 0; v < 5; ++v) red[(kq * 5 + v) * 32 + col] = acc[v];
        __syncthreads();
        if (F.tid < 160) { const int v = F.tid >> 5, c2 = F.tid & 31; float s = 0.f;
#pragma unroll
            for (int q = 0; q < 16; ++q) s += red[(q * 5 + v) * 32 + c2];
            ada[(l * 5 + v) * 6144 + j0 + c2] = s + bada[l * 6144 + j0 + c2]; }
        __syncthreads();
    }
    const int gt = F.vcu * NTHR + F.tid, GT = F.G * NTHR;
    f32x2* LAMB = (f32x2*)(F.ws + WS_LAMB); f32x2* LAMQ = (f32x2*)(F.ws + WS_LAMQ); f32x2* BBAR = (f32x2*)(F.ws + WS_BBAR); bf16* CMAT = (bf16*)(F.ws + WS_CMAT);
    for (int idx = gt; idx < 2 * 2 * 32 * 64; idx += GT) {
        const int l = idx >> 12, dir = (idx >> 11) & 1, g = (idx >> 6) & 31, p = idx & 63;
        const double dtv = exp((double)INP(I_LOGDT)[(l * 2 + dir) * 32 + g]);
        const double are = (double)INP(I_ARE)[idx], aim = (double)INP(I_AIM)[idx];
        const double er = exp(are * dtv), lr = er * cos(aim * dtv), li = er * sin(aim * dtv);
        const double eq = exp(64.0 * are * dtv), qr = eq * cos(64.0 * aim * dtv), qi = eq * sin(64.0 * aim * dtv);
        const double nr = lr - 1.0, ni = li, den = are * are + aim * aim;
        const double cr = (nr * are + ni * aim) / den, ci = (ni * are - nr * aim) / den;
        LAMB[idx] = (f32x2){(float)lr, (float)li}; LAMQ[idx] = (f32x2){(float)qr, (float)qi};
        const float* bre = INP(I_BRE) + ((size_t)(l * 32 + g) * 64 + p) * 16; const float* bim = INP(I_BIM) + ((size_t)(l * 32 + g) * 64 + p) * 16;
#pragma unroll 4
        for (int c = 0; c < 16; ++c) { const double br = bre[c], bi = bim[c]; BBAR[(size_t)idx * 16 + c] = (f32x2){(float)(cr * br - ci * bi), (float)(cr * bi + ci * br)}; }
    }
    for (int idx = gt; idx < 2 * 32 * 16 * 64; idx += GT) {
        const int p = idx & 63, lgc = idx >> 6;
        const float cre = INP(I_CRE)[idx], cim = INP(I_CIM)[idx];
        *(unsigned*)(CMAT + (size_t)lgc * 128 + 2 * p) = pk2(cre, -cim);
    }
}
__device__ __forceinline__ void transpose_item(const float* W, int ldw, int k0, int nsrc0, bf16* WT, int K, int ndst0, LAS float* scr, int lane) {
#pragma unroll 8
    for (int i = 0; i < 32; ++i) { const int kk = 2 * i + (lane >> 5); scr[kk * 33 + (lane & 31)] = W[(size_t)(k0 + kk) * ldw + nsrc0 + (lane & 31)]; }
    LDS_WAIT(); asm volatile("" ::: "memory");
    const int c = lane & 7;
#pragma unroll
    for (int j = 0; j < 4; ++j) { const int n = (lane >> 3) + 8 * j; const LAS float* s = scr + (8 * c) * 33 + n;
        v4u o; o.x = pk2(s[0 * 33], s[1 * 33]); o.y = pk2(s[2 * 33], s[3 * 33]); o.z = pk2(s[4 * 33], s[5 * 33]); o.w = pk2(s[6 * 33], s[7 * 33]);
        *(GAS v4u*)(WT + (size_t)(ndst0 + n) * K + k0 + 8 * c) = o; }
    LDS_WAIT(); asm volatile("" ::: "memory");
}
__device__ __forceinline__ void convert_weights(Frame& F, int l, int lds_off) {
    LAS float* scr = (LAS float*)(F.lds + lds_off + F.wave * 8448);
    const int gw = F.vcu * NWAVES + F.wave, NGW = F.G * NWAVES;
    constexpr int I_IN = 16 * 64, I_GL = 8 * 16, I_OUT = 16 * 32, I_UP = 16 * 176, I_DN = 44 * 32;
    constexpr int NIT = I_IN + I_GL + I_OUT + I_UP + I_DN;
    const float* win = INP(I_WIN) + (size_t)l * 1024 * DPROJ; const float* wglu = INP(I_GLUW) + (size_t)l * 512 * 512; const float* wout = INP(I_WOUT) + (size_t)l * 1024 * 1024;
    const float* wup = INP(I_WUP) + (size_t)l * 1024 * 5632; const float* wdn = INP(I_WDOWN) + (size_t)l * 2816 * 1024;
    for (int it = gw; it < NIT; it += NGW) {
        int r = it;
        if (r < I_IN) { const int kb = r >> 6, nb = r & 63, d0 = nb * 32, s0 = d0 < 1536 ? d0 : d0 + 16; transpose_item(win, DPROJ, kb * 64, s0, (bf16*)(F.ws + WS_WIN), 1024, d0, scr, F.lane); continue; } r -= I_IN;
        if (r < I_GL) { const int kb = r >> 4, nb = r & 15; transpose_item(wglu, 512, kb * 64, nb * 32, (bf16*)(F.ws + WS_WGLU), 512, nb * 32, scr, F.lane); continue; } r -= I_GL;
        if (r < I_OUT) { const int kb = r >> 5, nb = r & 31; transpose_item(wout, 1024, kb * 64, nb * 32, (bf16*)(F.ws + WS_WOUT), 1024, nb * 32, scr, F.lane); continue; } r -= I_OUT;
        if (r < I_UP) { const int kb = r / 176, nb = r % 176, d0 = nb * 32, pn = d0 >> 8, h = (d0 >> 7) & 1, j = d0 & 127, s0 = h * 2816 + 128 * pn + j;
            transpose_item(wup, 5632, kb * 64, s0, (bf16*)(F.ws + WS_WUP), 1024, d0, scr, F.lane); continue; } r -= I_UP;
        { const int kb = r >> 5, nb = r & 31; transpose_item(wdn, 1024, kb * 64, nb * 32, (bf16*)(F.ws + WS_WDOWN), 2816, nb * 32, scr, F.lane); }
    }
}
__device__ __forceinline__ float softplusf_(float x) { return x > 20.f ? x : log1pf(expf(x)); }
__device__ __forceinline__ void stage_wdt(Frame& F, int l) {
    LAS float* wdt = (LAS float*)F.lds;
    const float* win = INP(I_WIN) + (size_t)l * 1024 * DPROJ + 1536;
    for (int i = F.tid; i < 1024 * 4; i += NTHR) { const int k = i >> 2, q = i & 3; *(LAS f32x4*)(wdt + k * 16 + (k >> 2) * 4 + 4 * q) = *(const f32x4*)(win + (size_t)k * DPROJ + 4 * q); }
    __syncthreads();
}
__device__ __forceinline__ void norm1_row(Frame& F, int l, int r, const f32x4 (&xv)[4]) {
    const float* ada = (const float*)(F.ws + WS_ADA) + (size_t)(l * 5 + row_modv(r)) * 6144;
    const float* gp = INP(I_GPREMIX) + l * 1024;
    float ss = 0.f;
#pragma unroll
    for (int j = 0; j < 4; ++j) ss += (xv[j].x * xv[j].x + xv[j].y * xv[j].y) + (xv[j].z * xv[j].z + xv[j].w * xv[j].w);
    const float rstd = rsqrtf(wave_sum(ss) * (1.f / 1024.f) + EPS);
    f32x4 h[4];
    bf16* HX = (bf16*)(F.ws + WS_A) + (size_t)r * 1024;
#pragma unroll
    for (int j = 0; j < 4; ++j) { const int c = 4 * F.lane + 256 * j;
        const f32x4 g = *(const f32x4*)(gp + c), sh = *(const f32x4*)(ada + c), scl = *(const f32x4*)(ada + 1024 + c);
        h[j] = (xv[j] * rstd * g) * (scl + 1.0f) + sh;
        v2u o; o.x = pk2(h[j].x, h[j].y); o.y = pk2(h[j].z, h[j].w); *(v2u*)(HX + c) = o; }
    const LAS float* wdt = (const LAS float*)F.lds;
    float acc[16];
#pragma unroll
    for (int q = 0; q < 16; ++q) acc[q] = 0.f;
#pragma unroll
    for (int j = 0; j < 4; ++j) {
#pragma unroll
        for (int i = 0; i < 4; ++i) { const int k = 4 * F.lane + 256 * j + i; const float hv = h[j][i];
#pragma unroll
            for (int q4 = 0; q4 < 4; ++q4) { const f32x4 w = *(const LAS f32x4*)(wdt + k * 16 + (k >> 2) * 4 + 4 * q4);
                acc[4 * q4 + 0] += hv * w.x; acc[4 * q4 + 1] += hv * w.y; acc[4 * q4 + 2] += hv * w.z; acc[4 * q4 + 3] += hv * w.w; }
            asm volatile("" ::: "memory"); }
    }
    float mine = 0.f;
#pragma unroll
    for (int q = 0; q < 16; ++q) { const float s = wave_sum(acc[q]); if (F.lane == q) mine = s; }
    if (F.lane < 16) ((float*)(F.ws + WS_DT))[(size_t)r * 16 + F.lane] = softplusf_(mine + INP(I_DTBIAS)[l * 16 + F.lane]);
}
__device__ __forceinline__ void p1_norm1_first(Frame& F) {
    stage_wdt(F, 0);
    const int gw = F.vcu * NWAVES + F.wave, NGW = F.G * NWAVES;
    for (int r = gw; r < RT; r += NGW) {
        const float* xr = r < RC ? INP(I_CTX) + (size_t)r * 1024 : INP(I_X) + (size_t)(r - RC) * 1024;
        f32x4 xv[4];
#pragma unroll
        for (int j = 0; j < 4; ++j) xv[j] = *(const f32x4*)(xr + 4 * F.lane + 256 * j);
        norm1_row(F, 0, r, xv);
    }
}
__device__ __forceinline__ void rms_row(const f32x4 (&xv)[4], const float* g, int lane, f32x4 (&o)[4]) {
    float ss = 0.f;
#pragma unroll
    for (int j = 0; j < 4; ++j) ss += (xv[j].x * xv[j].x + xv[j].y * xv[j].y) + (xv[j].z * xv[j].z + xv[j].w * xv[j].w);
    const float rstd = rsqrtf(wave_sum(ss) * (1.f / 1024.f) + EPS);
#pragma unroll
    for (int j = 0; j < 4; ++j) o[j] = xv[j] * rstd * *(const f32x4*)(g + 4 * lane + 256 * j);
}
__device__ __forceinline__ const float* xsrc_row(Frame& F, int l, bool after_mix, int r) {
    if (l == 0 && !after_mix) return r < RC ? INP(I_CTX) + (size_t)r * 1024 : INP(I_X) + (size_t)(r - RC) * 1024;
    return r < RC ? (const float*)(F.ws + WS_CTXX) + (size_t)r * 1024 : F.out + (size_t)(r - RC) * 1024;
}
__device__ __forceinline__ float* xdst_row(Frame& F, int r) { return r < RC ? (float*)(F.ws + WS_CTXX) + (size_t)r * 1024 : F.out + (size_t)(r - RC) * 1024; }
__device__ __forceinline__ void p8_postmix(Frame& F, int l, int r_lo) {
    const int gw = F.vcu * NWAVES + F.wave, NGW = F.G * NWAVES;
    bf16* HX2 = (bf16*)(F.ws + WS_A);
    if (r_lo == 0) {
        for (int a = gw; a < 1280; a += NGW) { const int w = a % 320, blk = w >> 6, i = w & 63, tok = 62 * blk - 1 + i;
            if (tok < 0 || tok >= 256) { v4u z = {0u, 0u, 0u, 0u}; *(v4u*)(HX2 + (size_t)a * 1024 + 8 * F.lane) = z; *(v4u*)(HX2 + (size_t)a * 1024 + 512 + 8 * F.lane) = z; } }
    }
    for (int r = r_lo + gw; r < RT; r += NGW) {
        const float* ada = (const float*)(F.ws + WS_ADA) + (size_t)(l * 5 + row_modv(r)) * 6144;
        const float* xm = (const float*)(F.ws + WS_ZXU) + (size_t)r * 1024;
        const float* xr = xsrc_row(F, l, false, r);
        f32x4 mv[4], xv[4], nm[4];
#pragma unroll
        for (int j = 0; j < 4; ++j) { mv[j] = *(const f32x4*)(xm + 4 * F.lane + 256 * j); xv[j] = *(const f32x4*)(xr + 4 * F.lane + 256 * j); }
        rms_row(mv, INP(I_GPOSTMIX) + l * 1024, F.lane, nm);
        float* xo = xdst_row(F, r);
#pragma unroll
        for (int j = 0; j < 4; ++j) { const int c = 4 * F.lane + 256 * j; xv[j] = xv[j] + *(const f32x4*)(ada + 2 * 1024 + c) * nm[j]; *(f32x4*)(xo + c) = xv[j]; }
        rms_row(xv, INP(I_GPREFFN) + l * 1024, F.lane, nm);
        v2u o[4];
#pragma unroll
        for (int j = 0; j < 4; ++j) { const int c = 4 * F.lane + 256 * j; const f32x4 h = nm[j] * (*(const f32x4*)(ada + 4 * 1024 + c) + 1.0f) + *(const f32x4*)(ada + 3 * 1024 + c);
            o[j].x = pk2(h.x, h.y); o[j].y = pk2(h.z, h.w); }
        if (r >= RC) {
#pragma unroll
            for (int j = 0; j < 4; ++j) *(v2u*)(HX2 + (size_t)(1280 + r - RC) * 1024 + 4 * F.lane + 256 * j) = o[j];
        } else {
            const int b = r >> 8, t = r & 255;
            const int blk1 = t / 62;
            { const int a = b * 320 + blk1 * 64 + (t + 1 - 62 * blk1);
#pragma unroll
              for (int j = 0; j < 4; ++j) *(v2u*)(HX2 + (size_t)a * 1024 + 4 * F.lane + 256 * j) = o[j]; }
            const int i1 = t + 1 - 62 * blk1;
            if (i1 == 1 && blk1 > 0) { const int a = b * 320 + (blk1 - 1) * 64 + 63;
#pragma unroll
              for (int j = 0; j < 4; ++j) *(v2u*)(HX2 + (size_t)a * 1024 + 4 * F.lane + 256 * j) = o[j]; }
            if (i1 == 62 && blk1 < 4) { const int a = b * 320 + (blk1 + 1) * 64 + 0;
#pragma unroll
              for (int j = 0; j < 4; ++j) *(v2u*)(HX2 + (size_t)a * 1024 + 4 * F.lane + 256 * j) = o[j]; }
        }
    }
}
__device__ __forceinline__ void p11_postffn(Frame& F, int l, int r_lo) {
    if (l == 0) stage_wdt(F, 1);
    const int gw = F.vcu * NWAVES + F.wave, NGW = F.G * NWAVES;
    for (int r = r_lo + gw; r < RT; r += NGW) {
        const float* ada = (const float*)(F.ws + WS_ADA) + (size_t)(l * 5 + row_modv(r)) * 6144;
        const float* fo = (const float*)(F.ws + WS_FOUT) + (size_t)r * 1024;
        const float* xr = xsrc_row(F, l, true, r);
        f32x4 mv[4], xv[4], nm[4];
#pragma unroll
        for (int j = 0; j < 4; ++j) { mv[j] = *(const f32x4*)(fo + 4 * F.lane + 256 * j); xv[j] = *(const f32x4*)(xr + 4 * F.lane + 256 * j); }
        rms_row(mv, INP(I_GPOSTFFN) + l * 1024, F.lane, nm);
        float* xo = xdst_row(F, r);
#pragma unroll
        for (int j = 0; j < 4; ++j) { const int c = 4 * F.lane + 256 * j; xv[j] = xv[j] + *(const f32x4*)(ada + 5 * 1024 + c) * nm[j]; *(f32x4*)(xo + c) = xv[j]; }
        if (l == 0) norm1_row(F, 1, r, xv);
    }
}
__device__ __forceinline__ f32x4 mfma16(bf16x8 a, bf16x8 b, f32x4 c) { return __builtin_amdgcn_mfma_f32_16x16x32_bf16(a, b, c, 0, 0, 0); }
constexpr float LOG2E = 1.4426950408889634f;
struct ChunkInfo { int r0, b, slot; bool hp, hn; };
__device__ __forceinline__ ChunkInfo chunk_info(int cidx) {
    ChunkInfo c; c.r0 = cidx * 128;
    if (cidx < 8) { c.b = cidx >> 1; const int cp = cidx & 1; c.slot = cp; c.hp = cp > 0; c.hn = cp < 1; }
    else { const int k = cidx - 8; c.b = k >> 5; const int cp = k & 31; c.slot = 2 + cp; c.hp = cp > 0; c.hn = cp < 31; }
    return c;
}
template <int NCOLS>
__device__ __forceinline__ void load_conv_tile(Frame& F, int l, int r0, bool hp, bool hn, int c0, LAS bf16* dst, int ld) {
    const bf16* Z = (const bf16*)(F.ws + WS_ZXU);
    const float* cw = INP(I_SCONVW) + l * 3 * 1024; const float* cb = INP(I_SCONVB) + l * 1024;
    constexpr int CG = NCOLS / 8;
    for (int it = F.tid; it < 128 * CG; it += NTHR) {
        const int row = it / CG, cg = it % CG, ch = c0 + 8 * cg;
        const bf16* p = Z + (size_t)(r0 + row) * 2048 + 512 + ch;
        const v4u z4 = {0u, 0u, 0u, 0u};
        const v4u cur = *(const v4u*)p;
        const v4u prv = (row > 0 || hp) ? *(const v4u*)(p - 2048) : z4;
        const v4u nxt = (row < 127 || hn) ? *(const v4u*)(p + 2048) : z4;
        float o[8];
#pragma unroll
        for (int q = 0; q < 2; ++q) {
            const f32x4 w0 = *(const f32x4*)(cw + ch + 4 * q), w1 = *(const f32x4*)(cw + 1024 + ch + 4 * q), w2 = *(const f32x4*)(cw + 2048 + ch + 4 * q), bb = *(const f32x4*)(cb + ch + 4 * q);
            const unsigned pa = q == 0 ? prv.x : prv.z, pb = q == 0 ? prv.y : prv.w, ca = q == 0 ? cur.x : cur.z, cbb = q == 0 ? cur.y : cur.w, na = q == 0 ? nxt.x : nxt.z, nb = q == 0 ? nxt.y : nxt.w;
            o[4 * q + 0] = siluf_(bb.x + w0.x * bflo(pa) + w1.x * bflo(ca) + w2.x * bflo(na));
            o[4 * q + 1] = siluf_(bb.y + w0.y * bfhi(pa) + w1.y * bfhi(ca) + w2.y * bfhi(na));
            o[4 * q + 2] = siluf_(bb.z + w0.z * bflo(pb) + w1.z * bflo(cbb) + w2.z * bflo(nb));
            o[4 * q + 3] = siluf_(bb.w + w0.w * bfhi(pb) + w1.w * bfhi(cbb) + w2.w * bfhi(nb));
        }
        v4u w; w.x = pk2(o[0], o[1]); w.y = pk2(o[2], o[3]); w.z = pk2(o[4], o[5]); w.w = pk2(o[6], o[7]);
        *(LAS v4u*)(dst + row * ld + 8 * cg) = w;
    }
}
constexpr int XS_LD = 264, BS_LD = 136;
constexpr int L_XS = 0, L_BS = L_XS + 128 * XS_LD * 2, L_CS = L_BS + 128 * BS_LD * 2, L_ARR = L_CS + 128 * BS_LD * 2;
constexpr int L_SSQ = L_ARR + 6 * 2048;
static_assert(L_SSQ + 2048 <= 162816, "SSD LDS map");
__device__ __forceinline__ void ssd_decay_arrays(Frame& F, int l, int r0, int g) {
    LAS float* arr = (LAS float*)(F.lds + L_ARR);
    const float* DT = (const float*)(F.ws + WS_DT);
    for (int i = F.tid; i < 1024; i += NTHR) { const int j = i >> 3, de = i & 7, dir = de >> 2, e = de & 3;
        arr[(2 + dir) * 512 + e * 128 + j] = DT[(size_t)(r0 + j) * 16 + dir * 8 + 4 * g + e]; }
    __syncthreads();
    if (F.tid < 8) { const int dir = F.tid >> 2, e = F.tid & 3;
        const float a = -expf(INP(I_ALOG)[l * 16 + dir * 8 + 4 * g + e]) * LOG2E;
        LAS float* d = arr + (2 + dir) * 512 + e * 128; LAS float* c = arr + dir * 512 + e * 128;
        float s = 0.f;
        if (dir == 0) { for (int j = 0; j < 128; ++j) { s += d[j] * a; c[j] = s; } }
        else { for (int j = 127; j >= 0; --j) { s += d[j] * a; c[j] = s; } }
    }
    __syncthreads();
    for (int i = F.tid; i < 1024; i += NTHR) { const int j = i & 127, de = i >> 7, dir = de >> 2, e = de & 3;
        const LAS float* c = arr + dir * 512 + e * 128; const float tot = dir == 0 ? c[127] : c[0];
        arr[(4 + dir) * 512 + e * 128 + j] = arr[(2 + dir) * 512 + e * 128 + j] * exp2f(tot - c[j]); }
    __syncthreads();
}
__device__ __forceinline__ void ssd_states_item(Frame& F, int l, int cidx, int g) {
    const ChunkInfo ci = chunk_info(cidx);
    LAS bf16* xs = (LAS bf16*)(F.lds + L_XS); LAS bf16* Bs = (LAS bf16*)(F.lds + L_BS);
    LAS float* arr = (LAS float*)(F.lds + L_ARR);
    load_conv_tile<256>(F, l, ci.r0, ci.hp, ci.hn, 256 * g, xs, XS_LD);
    load_conv_tile<128>(F, l, ci.r0, ci.hp, ci.hn, 512 + 128 * g, Bs, BS_LD);
    ssd_decay_arrays(F, l, ci.r0, g);
    const int w = F.wave, lane = F.lane, lr = lane & 15, q = lane >> 4, e = w >> 1;
    float* ST = (float*)(F.ws + WS_A);
#pragma unroll 1
    for (int dir = 0; dir < 2; ++dir) {
        f32x4 acc[2][8];
#pragma unroll
        for (int rt = 0; rt < 2; ++rt)
#pragma unroll
            for (int nt = 0; nt < 8; ++nt) acc[rt][nt] = (f32x4){0.f, 0.f, 0.f, 0.f};
        const LAS float* wd = arr + (4 + dir) * 512 + e * 128;
#pragma unroll 1
        for (int kt = 0; kt < 4; ++kt) {
            const int j0 = 32 * kt + 8 * q;
            bf16x8 bfr[8];
#pragma unroll
            for (int nt = 0; nt < 8; ++nt)
#pragma unroll
                for (int jj = 0; jj < 8; ++jj) bfr[nt][jj] = (short)Bs[(j0 + jj) * BS_LD + 16 * nt + lr];
#pragma unroll
            for (int rt = 0; rt < 2; ++rt) {
                const int col = 32 * w + 16 * rt + lr;
                bf16x8 af;
#pragma unroll
                for (int jj = 0; jj < 8; ++jj) { const float xv = bf2f(xs[(j0 + jj) * XS_LD + col]); af[jj] = (short)f2bf(xv * wd[j0 + jj]); }
#pragma unroll
                for (int nt = 0; nt < 8; ++nt) acc[rt][nt] = mfma16(af, bfr[nt], acc[rt][nt]);
            }
        }
        float* st = ST + ((((size_t)ci.b * 2 + dir) * NSLOT + ci.slot) * 2 + g) * 32768;
#pragma unroll
        for (int rt = 0; rt < 2; ++rt)
#pragma unroll
            for (int nt = 0; nt < 8; ++nt)
#pragma unroll
                for (int rg = 0; rg < 4; ++rg) { const int row = 32 * w + 16 * rt + 4 * q + rg, col = 16 * nt + lr; st[row * 128 + col] = acc[rt][nt][rg]; }
    }
    if (F.tid < 8) { const int dir = F.tid >> 2, ee = F.tid & 3; const LAS float* c = arr + dir * 512 + ee * 128;
        ((float*)(F.ws + WS_DEC))[((((size_t)ci.b * 2 + dir) * NSLOT + ci.slot) * 2 + g) * 4 + ee] = exp2f(dir == 0 ? c[127] : c[0]); }
    __syncthreads();
}
__device__ __forceinline__ void ssd_out_item(Frame& F, int l, int cidx, int g) {
    const ChunkInfo ci = chunk_info(cidx);
    LAS bf16* xs = (LAS bf16*)(F.lds + L_XS); LAS bf16* Bs = (LAS bf16*)(F.lds + L_BS); LAS bf16* Cs = (LAS bf16*)(F.lds + L_CS);
    LAS float* arr = (LAS float*)(F.lds + L_ARR); LAS float* ssq = (LAS float*)(F.lds + L_SSQ);
    load_conv_tile<256>(F, l, ci.r0, ci.hp, ci.hn, 256 * g, xs, XS_LD);
    load_conv_tile<128>(F, l, ci.r0, ci.hp, ci.hn, 512 + 128 * g, Bs, BS_LD);
    load_conv_tile<128>(F, l, ci.r0, ci.hp, ci.hn, 768 + 128 * g, Cs, BS_LD);
    ssd_decay_arrays(F, l, ci.r0, g);
    const int w = F.wave, lane = F.lane, lr = lane & 15, q = lane >> 4;
    {
        f32x4 cacc[8];
#pragma unroll
        for (int jt = 0; jt < 8; ++jt) cacc[jt] = (f32x4){0.f, 0.f, 0.f, 0.f};
#pragma unroll
        for (int kt = 0; kt < 4; ++kt) {
            const bf16x8 a = *(const LAS bf16x8*)(Cs + (16 * w + lr) * BS_LD + 32 * kt + 8 * q);
#pragma unroll
            for (int jt = 0; jt < 8; ++jt) { const bf16x8 b = *(const LAS bf16x8*)(Bs + (16 * jt + lr) * BS_LD + 32 * kt + 8 * q); cacc[jt] = mfma16(a, b, cacc[jt]); }
        }
        __syncthreads();
#pragma unroll
        for (int jt = 0; jt < 8; ++jt)
#pragma unroll
            for (int rg = 0; rg < 4; ++rg) Bs[(16 * w + 4 * q + rg) * BS_LD + 16 * jt + lr] = (bf16)f2bf(cacc[jt][rg]);
        __syncthreads();
    }
    LAS bf16* cbs = Bs;
    const int e = w >> 1, mh = w & 1, head = 4 * g + e;
    const LAS float* cumf = arr + 0 * 512 + e * 128; const LAS float* crev = arr + 1 * 512 + e * 128; const LAS float* dtf = arr + 2 * 512 + e * 128; const LAS float* dtb = arr + 3 * 512 + e * 128;
    f32x4 acc[4][4];
#pragma unroll
    for (int mt = 0; mt < 4; ++mt)
#pragma unroll
        for (int pt = 0; pt < 4; ++pt) acc[mt][pt] = (f32x4){0.f, 0.f, 0.f, 0.f};
#pragma unroll 1
    for (int kt = 0; kt < 4; ++kt) {
        const int j0 = 32 * kt + 8 * q;
        bf16x8 bx[4];
#pragma unroll
        for (int pt = 0; pt < 4; ++pt)
#pragma unroll
            for (int jj = 0; jj < 8; ++jj) bx[pt][jj] = (short)xs[(j0 + jj) * XS_LD + 64 * e + 16 * pt + lr];
        float cfj[8], crj[8], dfj[8], dbj[8];
#pragma unroll
        for (int jj = 0; jj < 8; ++jj) { cfj[jj] = cumf[j0 + jj]; crj[jj] = crev[j0 + jj]; dfj[jj] = dtf[j0 + jj]; dbj[jj] = dtb[j0 + jj]; }
#pragma unroll
        for (int mt = 0; mt < 4; ++mt) {
            const int i = 16 * (4 * mh + mt) + lr;
            const float cfi = cumf[i], cri = crev[i];
            const bf16x8 cbv = *(const LAS bf16x8*)(cbs + i * BS_LD + j0);
            bf16x8 a;
#pragma unroll
            for (int jj = 0; jj < 8; ++jj) { const int j = j0 + jj;
                float Lw;
                if (j < i) Lw = exp2f(cfi - cfj[jj]) * dfj[jj];
                else if (j > i) Lw = exp2f(cri - crj[jj]) * dbj[jj];
                else Lw = dfj[jj] + dbj[jj];
                a[jj] = (short)f2bf(bf2f((unsigned short)cbv[jj]) * Lw); }
#pragma unroll
            for (int pt = 0; pt < 4; ++pt) acc[mt][pt] = mfma16(a, bx[pt], acc[mt][pt]);
        }
    }
    const float* ST = (const float*)(F.ws + WS_A);
#pragma unroll 1
    for (int dir = 0; dir < 2; ++dir) {
        const float* H = ST + ((((size_t)ci.b * 2 + dir) * NSLOT + ci.slot) * 2 + g) * 32768 + (size_t)(64 * e) * 128;
        const LAS float* cc = dir == 0 ? cumf : crev;
#pragma unroll 1
        for (int kt = 0; kt < 4; ++kt) {
            bf16x8 bh[4];
#pragma unroll
            for (int pt = 0; pt < 4; ++pt) { const float* hp = H + (size_t)(16 * pt + lr) * 128 + 32 * kt + 8 * q; const f32x4 h0 = *(const f32x4*)hp, h1 = *(const f32x4*)(hp + 4);
                bh[pt][0] = (short)f2bf(h0.x); bh[pt][1] = (short)f2bf(h0.y); bh[pt][2] = (short)f2bf(h0.z); bh[pt][3] = (short)f2bf(h0.w);
                bh[pt][4] = (short)f2bf(h1.x); bh[pt][5] = (short)f2bf(h1.y); bh[pt][6] = (short)f2bf(h1.z); bh[pt][7] = (short)f2bf(h1.w); }
#pragma unroll
            for (int mt = 0; mt < 4; ++mt) {
                const int i = 16 * (4 * mh + mt) + lr;
                const float sc = exp2f(cc[i]);
                const bf16x8 cv = *(const LAS bf16x8*)(Cs + i * BS_LD + 32 * kt + 8 * q);
                bf16x8 a;
#pragma unroll
                for (int jj = 0; jj < 8; ++jj) a[jj] = (short)f2bf(bf2f((unsigned short)cv[jj]) * sc);
#pragma unroll
                for (int pt = 0; pt < 4; ++pt) acc[mt][pt] = mfma16(a, bh[pt], acc[mt][pt]);
            }
        }
    }
    const float Dh = INP(I_SSDD)[l * 8 + head];
    const bf16* Z = (const bf16*)(F.ws + WS_ZXU); bf16* MIX = (bf16*)(F.ws + WS_MIX);
#pragma unroll
    for (int mt = 0; mt < 4; ++mt)
#pragma unroll
        for (int rg = 0; rg < 4; ++rg) {
            const int i = 16 * (4 * mh + mt) + 4 * q + rg;
            float s2 = 0.f;
#pragma unroll
            for (int pt = 0; pt < 4; ++pt) { const int p = 16 * pt + lr, col = 64 * head + p;
                const float y = acc[mt][pt][rg] + Dh * bf2f(xs[i * XS_LD + 64 * e + p]);
                const float z = bf2f(Z[(size_t)(ci.r0 + i) * 2048 + col]);
                const float v = y * siluf_(z);
                s2 += v * v;
                MIX[(size_t)(ci.r0 + i) * 1024 + col] = (bf16)f2bf(v); }
            s2 += __shfl_xor(s2, 1); s2 += __shfl_xor(s2, 2); s2 += __shfl_xor(s2, 4); s2 += __shfl_xor(s2, 8);
            if (lr == 0) ssq[e * 128 + i] = s2;
        }
    __syncthreads();
    if (F.tid < 128) ((float*)(F.ws + WS_SSQ))[(size_t)(ci.r0 + F.tid) * 2 + g] = (ssq[F.tid] + ssq[128 + F.tid]) + (ssq[256 + F.tid] + ssq[384 + F.tid]);
    __syncthreads();
}
template <int DIR>
__device__ __forceinline__ void ssd_scan_lane(float* __restrict__ ST, const float* __restrict__ DEC, int b, int g, int ep, int n4) {
    const size_t base = (((size_t)b * 2 + DIR) * NSLOT) * 2 * 32768 + (size_t)g * 32768 + (size_t)ep * 128 + 4 * n4;
    const size_t dbase = (((size_t)b * 2 + DIR) * NSLOT) * 8 + g * 4 + (ep >> 6);
    f32x4 h = {0.f, 0.f, 0.f, 0.f};
#pragma unroll
    for (int half = 0; half < 2; ++half) {
        f32x4 s[17]; float d[17];
#pragma unroll
        for (int k = 0; k < 17; ++k) { const int kk = 17 * half + k; const int slot = DIR == 0 ? kk : (kk == 0 ? 1 : (kk == 1 ? 0 : NSLOT + 1 - kk));
            s[k] = *(const f32x4*)(ST + base + (size_t)slot * 65536); d[k] = DEC[dbase + slot * 8]; }
#pragma unroll
        for (int k = 0; k < 17; ++k) { const int kk = 17 * half + k; const int slot = DIR == 0 ? kk : (kk == 0 ? 1 : (kk == 1 ? 0 : NSLOT + 1 - kk));
            *(f32x4*)(ST + base + (size_t)slot * 65536) = h; h = h * d[k] + s[k]; }
    }
}
__device__ __forceinline__ void p4_scans(Frame& F, int l) {
    float* ST = (float*)(F.ws + WS_A); const float* DEC = (const float*)(F.ws + WS_DEC);
    const int gt = F.vcu * NTHR + F.tid, GT = F.G * NTHR;
    for (int idx = gt; idx < 4 * 2 * 2 * 256 * 32; idx += GT) {
        const int n4 = idx & 31, ep = (idx >> 5) & 255, g = (idx >> 13) & 1, dir = (idx >> 14) & 1, b = idx >> 15;
        if (dir == 0) ssd_scan_lane<0>(ST, DEC, b, g, ep, n4); else ssd_scan_lane<1>(ST, DEC, b, g, ep, n4);
    }
    f32x2* S5 = (f32x2*)(F.ws + WS_S5ST); const f32x2* LAMQ = (const f32x2*)(F.ws + WS_LAMQ);
    for (int idx = gt; idx < 4 * 2 * 2048; idx += GT) {
        const int gp = idx & 2047, dir = (idx >> 11) & 1, b = idx >> 12;
        const f32x2 lq = LAMQ[(l * 2 + dir) * 2048 + gp];
        f32x2* base = S5 + (((size_t)b * 2 + dir) * NSLOT5) * 2048 + gp;
        f32x2 h = {0.f, 0.f};
#pragma unroll 1
        for (int part = 0; part < 4; ++part) {
            f32x2 s[17];
#pragma unroll
            for (int k = 0; k < 17; ++k) { const int kk = 17 * part + k; const int slot = dir == 0 ? kk : (kk < 4 ? 3 - kk : NSLOT5 + 3 - kk); s[k] = base[(size_t)slot * 2048]; }
#pragma unroll
            for (int k = 0; k < 17; ++k) { const int kk = 17 * part + k; const int slot = dir == 0 ? kk : (kk < 4 ? 3 - kk : NSLOT5 + 3 - kk);
                base[(size_t)slot * 2048] = h; h = (f32x2){lq.x * h.x - lq.y * h.y + s[k].x, lq.x * h.y + lq.y * h.x + s[k].y}; }
        }
    }
}
__device__ __forceinline__ int s5_row0(int b, int n64) { return n64 < 4 ? b * 256 + 64 * n64 : RC + b * 4096 + 64 * (n64 - 4); }
__device__ __forceinline__ void s5_load_u(Frame& F, int r0, int g, LAS float* ub) {
    const bf16* Z = (const bf16*)(F.ws + WS_ZXU);
    const v4u a = *(const v4u*)(Z + (size_t)(r0 + F.lane) * 2048 + 1536 + 16 * g), c = *(const v4u*)(Z + (size_t)(r0 + F.lane) * 2048 + 1536 + 16 * g + 8);
    LAS f32x4* d = (LAS f32x4*)(ub + F.lane * 16);
    d[0] = (f32x4){bflo(a.x), bfhi(a.x), bflo(a.y), bfhi(a.y)}; d[1] = (f32x4){bflo(a.z), bfhi(a.z), bflo(a.w), bfhi(a.w)};
    d[2] = (f32x4){bflo(c.x), bfhi(c.x), bflo(c.y), bfhi(c.y)}; d[3] = (f32x4){bflo(c.z), bfhi(c.z), bflo(c.w), bfhi(c.w)};
    LDS_WAIT(); asm volatile("" ::: "memory");
}
__device__ __forceinline__ f32x2 s5_bu(const f32x2 (&bb)[16], const LAS float* ut) {
    const f32x4 u0 = *(const LAS f32x4*)(ut), u1 = *(const LAS f32x4*)(ut + 4), u2 = *(const LAS f32x4*)(ut + 8), u3 = *(const LAS f32x4*)(ut + 12);
    const float u[16] = {u0.x, u0.y, u0.z, u0.w, u1.x, u1.y, u1.z, u1.w, u2.x, u2.y, u2.z, u2.w, u3.x, u3.y, u3.z, u3.w};
    float re = 0.f, im = 0.f;
#pragma unroll
    for (int c = 0; c < 16; ++c) { re += bb[c].x * u[c]; im += bb[c].y * u[c]; }
    return (f32x2){re, im};
}
__device__ __forceinline__ void s5_local_item(Frame& F, int l, int item, LAS float* ub) {
    const int n64 = item % NSLOT5, g = (item / NSLOT5) & 31, b = item / (NSLOT5 * 32);
    const int r0 = s5_row0(b, n64), p = F.lane;
    s5_load_u(F, r0, g, ub);
    f32x2* S5 = (f32x2*)(F.ws + WS_S5ST);
#pragma unroll 1
    for (int dir = 0; dir < 2; ++dir) {
        const int tix = ((l * 2 + dir) * 32 + g) * 64 + p;
        const f32x2 lam = ((const f32x2*)(F.ws + WS_LAMB))[tix];
        f32x2 bb[16];
        const f32x4* bp = (const f32x4*)((const f32x2*)(F.ws + WS_BBAR) + (size_t)tix * 16);
#pragma unroll
        for (int c = 0; c < 8; ++c) { const f32x4 v = bp[c]; bb[2 * c] = (f32x2){v.x, v.y}; bb[2 * c + 1] = (f32x2){v.z, v.w}; }
        f32x2 h = {0.f, 0.f};
#pragma unroll 4
        for (int k = 0; k < 64; ++k) { const int t = dir == 0 ? k : 63 - k; const f32x2 bu = s5_bu(bb, ub + t * 16);
            h = (f32x2){lam.x * h.x - lam.y * h.y + bu.x, lam.x * h.y + lam.y * h.x + bu.y}; }
        S5[(((size_t)b * 2 + dir) * NSLOT5 + n64) * 2048 + g * 64 + p] = h;
    }
}
__device__ __forceinline__ float gelu_tanh(float x) { const float u = 0.7978845608028654f * (x + 0.044715f * x * x * x); return 0.5f * x * (1.0f + tanhf(u)); }
__device__ __forceinline__ void s5_out_item(Frame& F, int l, int item, LAS float* ub, LAS unsigned* hb) {
    const int n64 = item % NSLOT5, g = (item / NSLOT5) & 31, b = item / (NSLOT5 * 32);
    const int r0 = s5_row0(b, n64), p = F.lane, lr = F.lane & 15, q = F.lane >> 4;
    s5_load_u(F, r0, g, ub);
    const f32x2* S5 = (const f32x2*)(F.ws + WS_S5ST);
    bf16x8 cm[4];
    const bf16* CM = (const bf16*)(F.ws + WS_CMAT) + ((size_t)(l * 32 + g) * 16 + lr) * 128;
#pragma unroll
    for (int kt = 0; kt < 4; ++kt) cm[kt] = *(const bf16x8*)(CM + 32 * kt + 8 * q);
    f32x4 acc[4];
#pragma unroll
    for (int tb = 0; tb < 4; ++tb) acc[tb] = (f32x4){0.f, 0.f, 0.f, 0.f};
#pragma unroll 1
    for (int dir = 0; dir < 2; ++dir) {
        const int tix = ((l * 2 + dir) * 32 + g) * 64 + p;
        const f32x2 lam = ((const f32x2*)(F.ws + WS_LAMB))[tix];
        f32x2 bb[16];
        const f32x4* bp = (const f32x4*)((const f32x2*)(F.ws + WS_BBAR) + (size_t)tix * 16);
#pragma unroll
        for (int c = 0; c < 8; ++c) { const f32x4 v = bp[c]; bb[2 * c] = (f32x2){v.x, v.y}; bb[2 * c + 1] = (f32x2){v.z, v.w}; }
        f32x2 h = S5[(((size_t)b * 2 + dir) * NSLOT5 + n64) * 2048 + g * 64 + p];
#pragma unroll
        for (int kb = 0; kb < 4; ++kb) {
            const int tb = dir == 0 ? kb : 3 - kb;
#pragma unroll 4
            for (int kk = 0; kk < 16; ++kk) { const int tt = dir == 0 ? kk : 15 - kk, t = 16 * tb + tt; const f32x2 bu = s5_bu(bb, ub + t * 16);
                h = (f32x2){lam.x * h.x - lam.y * h.y + bu.x, lam.x * h.y + lam.y * h.x + bu.y};
                hb[tt * 64 + p] = pk2(h.x, h.y); }
            LDS_WAIT(); asm volatile("" ::: "memory");
#pragma unroll
            for (int kt = 0; kt < 4; ++kt) { const bf16x8 a = *(const LAS bf16x8*)((const LAS bf16*)hb + lr * 128 + 32 * kt + 8 * q); acc[tb] = mfma16(a, cm[kt], acc[tb]); }
            LDS_WAIT(); asm volatile("" ::: "memory");
        }
    }
    bf16* G = (bf16*)(F.ws + WS_G);
    const float Dc = INP(I_S5D)[l * 512 + 16 * g + lr];
#pragma unroll
    for (int tb = 0; tb < 4; ++tb)
#pragma unroll
        for (int rg = 0; rg < 4; ++rg) { const int t = 16 * tb + 4 * q + rg; const float y = acc[tb][rg] + Dc * ub[t * 16 + lr];
            G[(size_t)(r0 + t) * 512 + 16 * g + lr] = (bf16)f2bf(gelu_tanh(y)); }
    LDS_WAIT(); asm volatile("" ::: "memory");
}
__device__ __forceinline__ void rescale_ssd_rows(Frame& F, int l, int r_lo) {
    const int gw = F.vcu * NWAVES + F.wave, NGW = F.G * NWAVES;
    const float* SSQ = (const float*)(F.ws + WS_SSQ); bf16* MIX = (bf16*)(F.ws + WS_MIX);
    const float* ng = INP(I_SNORMG) + l * 512 + 8 * F.lane;
    const f32x4 g0 = *(const f32x4*)ng, g1 = *(const f32x4*)(ng + 4);
    for (int r = r_lo + gw; r < RT; r += NGW) {
        const float sc = rsqrtf((SSQ[(size_t)r * 2] + SSQ[(size_t)r * 2 + 1]) * (1.f / 512.f) + EPS);
        v4u v = *(const v4u*)(MIX + (size_t)r * 1024 + 8 * F.lane);
        v.x = pk2(bflo(v.x) * sc * g0.x, bfhi(v.x) * sc * g0.y); v.y = pk2(bflo(v.y) * sc * g0.z, bfhi(v.y) * sc * g0.w);
        v.z = pk2(bflo(v.z) * sc * g1.x, bfhi(v.z) * sc * g1.y); v.w = pk2(bflo(v.w) * sc * g1.z, bfhi(v.w) * sc * g1.w);
        *(v4u*)(MIX + (size_t)r * 1024 + 8 * F.lane) = v;
    }
}
#ifndef PH_MASK
#define PH_MASK 0xFFFF
#endif
#define PH(k) if constexpr (((PH_MASK) >> (k)) & 1)
#define LAUNDER() do { unsigned long long w_ = (unsigned long long)F.ws, o_ = (unsigned long long)F.out; asm volatile("" : "+s"(w_), "+s"(o_), "+v"(F.tid), "+v"(F.lane), "+s"(F.wave), "+s"(F.vcu)); F.ws = (unsigned char*)(GAS unsigned char*)w_; F.out = (float*)(GAS float*)o_; } while (0)
struct Args { const float* in[N_IN]; float* out; unsigned char* ws; };
__global__ void __launch_bounds__(NTHR, 2) mega_fwd(Args args) {
    extern __shared__ __attribute__((aligned(16))) unsigned char lds[];
    Frame F;
    F.lds = (LAS unsigned char*)lds;
    F.MISC = (volatile LAS unsigned*)(F.lds + MISC_OFF);
    F.tid = threadIdx.x; F.lane = F.tid & 63; F.wave = __builtin_amdgcn_readfirstlane(F.tid >> 6);
    F.G = gridDim.x; { const int bx = blockIdx.x; F.vcu = (F.G % 8 == 0) ? (bx % 8) * (F.G / 8) + bx / 8 : bx; }
    F.out = args.out; F.ws = args.ws;
    F.ctl = (gu32*)(F.ws + WS_CTL);
    for (int u = F.tid; u < (LDS_BYTES - LDSCTL_OFF) / 4; u += NTHR) ((LAS unsigned*)(F.lds + LDSCTL_OFF))[u] = 0u;
    if (F.tid < N_IN) ((LAS unsigned long long*)(F.lds + PTAB_OFF))[F.tid] = (unsigned long long)args.in[F.tid];
    F.ptab = (const LAS unsigned long long*)(F.lds + PTAB_OFF);
    __syncthreads();
    XcdBarrier bar = xcd_barrier_post((unsigned*)(F.ctl + CW_BAR), F.MISC + 8);
#define GRID_BAR() do { xcd_barrier(bar); LAUNDER(); } while (0)
    const int bid = (int)blockIdx.x;

    PH(0) { p0_ada_tables(F); LAUNDER(); convert_weights(F, 0, 32768); }
    GRID_BAR();
    PH(1) p1_norm1_first(F);
    GRID_BAR();

#pragma unroll 1
    for (int l = 0; l < DEPTH; ++l) {
        const bool last = (l == DEPTH - 1);
        const int r_lo = last ? RC : 0;
        const int t_lo = r_lo / 256, Mrows = RT - r_lo;
        PH(2) {
            pg8::Gemm g{(const bf16*)(F.ws + WS_A), (const bf16*)(F.ws + WS_WIN), RT, NZXU, 1024}; pg8::StaticOrder S; S.init(RT, NZXU, F.G, bid);
            pg8::EpiStoreBf16 E{(bf16*)(F.ws + WS_ZXU), NZXU};
            pg8::gemm_phase<pg8::EpiStoreBf16, pg8::StaticOrder, true, true>(F.lds, g, S, E, F.tid);
        }
        GRID_BAR();
        PH(3) for (int it = F.vcu; it < 272; it += F.G) ssd_states_item(F, l, it >> 1, it & 1);
        __syncthreads(); LAUNDER();
        PH(12) {
            LAS float* ub = (LAS float*)(F.lds + F.wave * 8192);
            const int gw = F.vcu * NWAVES + F.wave, NGW = F.G * NWAVES;
            for (int it = gw; it < NB * 32 * NSLOT5; it += NGW) s5_local_item(F, l, it, ub);
        }
        GRID_BAR();
        PH(4) p4_scans(F, l);
        GRID_BAR();
        PH(5) for (int it = F.vcu; it < 272; it += F.G) { const int cidx = it >> 1; if (last && cidx < 8) continue; ssd_out_item(F, l, cidx, it & 1); }
        __syncthreads(); LAUNDER();
        PH(13) {
            LAS float* ub = (LAS float*)(F.lds + F.wave * 8192); LAS unsigned* hb = (LAS unsigned*)(F.lds + F.wave * 8192 + 4096);
            const int gw = F.vcu * NWAVES + F.wave, NGW = F.G * NWAVES;
            for (int it = gw; it < NB * 32 * NSLOT5; it += NGW) { if (last && (it % NSLOT5) < 4) continue; s5_out_item(F, l, it, ub, hb); }
        }
        GRID_BAR();
        PH(6) rescale_ssd_rows(F, l, r_lo);
        LAUNDER();
        PH(6) {
            const bf16* Gm = (const bf16*)(F.ws + WS_G) + (size_t)r_lo * 512;
            pg8::Gemm g{Gm, (const bf16*)(F.ws + WS_WGLU), Mrows, 512, 512}; pg8::StaticOrder S; S.init(Mrows, 512, F.G, bid);
            pg8::EpiGlu E{Gm, (bf16*)(F.ws + WS_MIX) + (size_t)r_lo * 1024 + 512, INP(I_GLUB) + l * 512};
            pg8::gemm_phase<pg8::EpiGlu, pg8::StaticOrder, true, true>(F.lds, g, S, E, F.tid);
        }
        GRID_BAR();
        PH(7) {
            pg8::Gemm g{(const bf16*)(F.ws + WS_MIX) + (size_t)r_lo * 1024, (const bf16*)(F.ws + WS_WOUT), Mrows, 1024, 1024}; pg8::StaticOrder S; S.init(Mrows, 1024, F.G, bid);
            pg8::EpiStoreF32 E{(float*)(F.ws + WS_ZXU) + (size_t)r_lo * 1024, 1024};
            pg8::gemm_phase<pg8::EpiStoreF32, pg8::StaticOrder, true, true>(F.lds, g, S, E, F.tid);
        }
        GRID_BAR();
        PH(8) p8_postmix(F, l, r_lo);
        GRID_BAR();
        PH(9) {
            const int tile0 = last ? 5 : 0, Mh = RH - tile0 * 256;
            pg8::Gemm g{(const bf16*)(F.ws + WS_A) + (size_t)tile0 * 256 * 1024, (const bf16*)(F.ws + WS_WUP), Mh, 5632, 1024}; pg8::StaticOrder S; S.init(Mh, 5632, F.G, bid);
            pg8::EpiFfnUp E{(bf16*)(F.ws + WS_HACT), INP(I_FCONVW) + (size_t)l * 3 * 5632, INP(I_FCONVB) + (size_t)l * 5632, tile0};
            pg8::gemm_phase<pg8::EpiFfnUp, pg8::StaticOrder, true, true>(F.lds, g, S, E, F.tid);
        }
        GRID_BAR();
        PH(10) {
            pg8::Gemm g{(const bf16*)(F.ws + WS_HACT) + (size_t)r_lo * 2816, (const bf16*)(F.ws + WS_WDOWN), Mrows, 1024, 2816}; pg8::StaticOrder S; S.init(Mrows, 1024, F.G, bid);
            pg8::EpiStoreF32 E{(float*)(F.ws + WS_FOUT) + (size_t)r_lo * 1024, 1024};
            pg8::gemm_phase<pg8::EpiStoreF32, pg8::StaticOrder, true, true>(F.lds, g, S, E, F.tid);
        }
        GRID_BAR();
        PH(11) p11_postffn(F, l, r_lo);
        if (!last) { __syncthreads(); LAUNDER(); PH(11) convert_weights(F, l + 1, 73728); GRID_BAR(); }
    }
}

extern "C" void kernel_launch(void* const* d_in, const int* in_sizes, int n_in, void* d_out, int out_size, void* d_ws, size_t ws_size, hipStream_t stream) {
    static int grid = 0;
    if (grid == 0) {
        if (n_in != N_IN || out_size != RL * DM || ws_size < WS_END) { fprintf(stderr, "kernel_launch: unexpected shapes (n_in %d, out %d, ws %zu); nothing launched\n", n_in, out_size, ws_size); grid = -1; return; }
        int dev = 0, cus = 0, per_cu = 0;
        if (hipGetDevice(&dev) != hipSuccess || hipDeviceGetAttribute(&cus, hipDeviceAttributeMultiprocessorCount, dev) != hipSuccess) { grid = -1; return; }
        if (hipFuncSetAttribute((const void*)mega_fwd, hipFuncAttributeMaxDynamicSharedMemorySize, LDS_BYTES) != hipSuccess) { fprintf(stderr, "kernel_launch: hipFuncSetAttribute failed\n"); grid = -1; return; }
        if (hipOccupancyMaxActiveBlocksPerMultiprocessor(&per_cu, (const void*)mega_fwd, NTHR, LDS_BYTES) != hipSuccess || per_cu < 1) { fprintf(stderr, "kernel_launch: occupancy query says %d\n", per_cu); }
        (void)hipGetLastError();
        grid = cus;
    }
    if (grid < 0) return;
    if (hipMemsetAsync((char*)d_ws + WS_CTL, 0, CTL_ZERO_BYTES, stream) != hipSuccess) return;
    Args a{};
    for (int i = 0; i < N_IN; ++i) a.in[i] = (const float*)d_in[i];
    a.out = (float*)d_out; a.ws = (unsigned char*)d_ws;
    hipLaunchKernelGGL(mega_fwd, dim3(grid), dim3(NTHR), LDS_BYTES, stream, a);
}
```

```cpp
#include <hip/hip_runtime.h>
#include <cstdio>
#include <cstdint>
namespace pg8 {
#define PG8_LAS __attribute__((address_space(3)))
typedef unsigned short bf16_t;
typedef short bf16x8 __attribute__((ext_vector_type(8)));
typedef float f32x4 __attribute__((ext_vector_type(4)));
typedef unsigned u32x4 __attribute__((ext_vector_type(4)));
constexpr int BM = 256, BK = 64, HALF = 128, HTB = HALF * BK * 2  , STAGE_BYTES = 8 * HTB, NXCD = 8, WGM = 8;

__host__ __device__ __forceinline__ int lds_byte(int r, int c) { const int st = (r >> 4) * 2 + (c >> 5), rr = r & 15, cc = c & 31, ob = rr * 64 + cc * 2; return st * 1024 + (ob ^ (((ob >> 9) & 1) << 5)); }
__host__ __device__ __forceinline__ void stage_rc(int b, int& R, int& C) { const int st = b / 1024, sb = b % 1024, swz = sb ^ (((sb >> 9) & 1) << 5); R = (st >> 1) * 16 + swz / 64; C = (st & 1) * 32 + (swz % 64) / 2; }
__host__ __device__ __forceinline__ int perm32(int rho) { const int n = rho >> 4, i = rho & 15; return 8 * (i >> 2) + 4 * n + (i & 3); }

struct Unit { int pm, pn; };
struct Gemm { const bf16_t* A; const bf16_t* Bt; int M, N, K; };

struct StaticOrder {
    int nM, nN, nwg, G, c;
    __host__ __device__ void init(int M, int N, int G_, int c_) { nM = M / BM; nN = N / BM; nwg = nM * nN; G = G_; c = c_; }
    __host__ __device__ bool next(int i, Unit& u) const {
        const long L = (long)i * G + c; if (L >= nwg) return false;
        int wgid = (int)L; { const int q = nwg / NXCD, r = nwg % NXCD, xcd = wgid % NXCD, off = wgid / NXCD; wgid = (xcd < r ? xcd * (q + 1) : r * (q + 1) + (xcd - r) * q) + off; }
        const int nig = WGM * nN, gid = wgid / nig, fm = gid * WGM, gsz = (nM - fm) < WGM ? (nM - fm) : WGM;
        u.pm = fm + ((wgid % nig) % gsz); u.pn = (wgid % nig) / gsz; return true;
    }
    __device__ __forceinline__ void a_ready(const Unit&) const {}
    __device__ __forceinline__ void done(const Unit&) const {}
};

__device__ __forceinline__ unsigned cvt_pk_bf16(float lo, float hi) { unsigned r; asm volatile("v_cvt_pk_bf16_f32 %0, %1, %2" : "=v"(r) : "v"(lo), "v"(hi)); return r; }
__device__ __forceinline__ float bf_lo(unsigned w) { return __uint_as_float(w << 16); }
__device__ __forceinline__ float bf_hi(unsigned w) { return __uint_as_float(w & 0xffff0000u); }
__device__ __forceinline__ float sigmoidf_(float x) { return 1.0f / (1.0f + __expf(-x)); }

struct EpiStoreBf16 {
    static constexpr bool PERM = true, AFTER_DRAIN = false;
    bf16_t* O; int ldc;
    __device__ __forceinline__ void operator()(const f32x4 (&acc)[2][2][4][2], const Unit& u, int wr, int wc, int fr, int fq) const {
        const int row0 = u.pm * BM + wr * 64 + fr, col0 = u.pn * BM + wc * 32 + 8 * fq;
#pragma unroll
        for (int ai = 0; ai < 2; ++ai)
#pragma unroll
            for (int m = 0; m < 4; ++m) { bf16_t* rowp = O + (size_t)(row0 + ai * HALF + m * 16) * ldc + col0;
#pragma unroll
                for (int bj = 0; bj < 2; ++bj) { const f32x4 v0 = acc[ai][bj][m][0], v1 = acc[ai][bj][m][1];
                    u32x4 w; w.x = cvt_pk_bf16(v0[0], v0[1]); w.y = cvt_pk_bf16(v0[2], v0[3]); w.z = cvt_pk_bf16(v1[0], v1[1]); w.w = cvt_pk_bf16(v1[2], v1[3]);
                    *(u32x4*)(rowp + bj * HALF) = w; } }
    }
};
struct EpiStoreF32 {
    static constexpr bool PERM = false, AFTER_DRAIN = false;
    float* C; int ldc;
    __device__ __forceinline__ void operator()(const f32x4 (&acc)[2][2][4][2], const Unit& u, int wr, int wc, int fr, int fq) const {
        const int row0 = u.pm * BM + wr * 64 + fr, col0 = u.pn * BM + wc * 32 + 4 * fq;
#pragma unroll
        for (int ai = 0; ai < 2; ++ai)
#pragma unroll
            for (int m = 0; m < 4; ++m) { float* rowp = C + (size_t)(row0 + ai * HALF + m * 16) * ldc + col0;
#pragma unroll
                for (int bj = 0; bj < 2; ++bj)
#pragma unroll
                    for (int n = 0; n < 2; ++n) *(f32x4*)(rowp + bj * HALF + n * 16) = acc[ai][bj][m][n]; }
    }
};
struct EpiGlu {
    static constexpr bool PERM = true, AFTER_DRAIN = false;
    const bf16_t* Gm; bf16_t* O; const float* bias;
    __device__ __forceinline__ void operator()(const f32x4 (&acc)[2][2][4][2], const Unit& u, int wr, int wc, int fr, int fq) const {
        const int row0 = u.pm * BM + wr * 64 + fr, col0 = u.pn * BM + wc * 32 + 8 * fq;
#pragma unroll
        for (int ai = 0; ai < 2; ++ai)
#pragma unroll
            for (int m = 0; m < 4; ++m) { const int r = row0 + ai * HALF + m * 16;
#pragma unroll
                for (int bj = 0; bj < 2; ++bj) { const int c = col0 + bj * HALF;
                    const u32x4 gv = *(const u32x4*)(Gm + (size_t)r * 512 + c);
                    const f32x4 b0 = *(const f32x4*)(bias + c), b1 = *(const f32x4*)(bias + c + 4);
                    const f32x4 v0 = acc[ai][bj][m][0] + b0, v1 = acc[ai][bj][m][1] + b1;
                    u32x4 w;
                    w.x = cvt_pk_bf16(bf_lo(gv.x) * sigmoidf_(v0[0]), bf_hi(gv.x) * sigmoidf_(v0[1]));
                    w.y = cvt_pk_bf16(bf_lo(gv.y) * sigmoidf_(v0[2]), bf_hi(gv.y) * sigmoidf_(v0[3]));
                    w.z = cvt_pk_bf16(bf_lo(gv.z) * sigmoidf_(v1[0]), bf_hi(gv.z) * sigmoidf_(v1[1]));
                    w.w = cvt_pk_bf16(bf_lo(gv.w) * sigmoidf_(v1[2]), bf_hi(gv.w) * sigmoidf_(v1[3]));
                    *(u32x4*)(O + (size_t)r * 1024 + c) = w; } }
    }
};
#ifndef FFN_USE_SHFL
__device__ __forceinline__ float dpp_prev(float cur, float below  , bool has_below) {
    const int old = has_below ? __builtin_amdgcn_update_dpp(0, __builtin_bit_cast(int, below), 0x121, 0xf, 0xf, false) : 0;
    return __builtin_bit_cast(float, __builtin_amdgcn_update_dpp(old, __builtin_bit_cast(int, cur), 0x111, 0xf, 0xf, false));
}
__device__ __forceinline__ float dpp_next(float cur, float above, bool has_above) {
    const int old = has_above ? __builtin_amdgcn_update_dpp(0, __builtin_bit_cast(int, above), 0x12F, 0xf, 0xf, false) : 0;
    return __builtin_bit_cast(float, __builtin_amdgcn_update_dpp(old, __builtin_bit_cast(int, cur), 0x101, 0xf, 0xf, false));
}
#endif
struct EpiFfnUp {
    static constexpr bool PERM = true, AFTER_DRAIN = false;
    bf16_t* H; const float* cw; const float* cb; int tile0;
    __device__ __forceinline__ void operator()(const f32x4 (&acc)[2][2][4][2], const Unit& u, int wr, int wc, int fr, int fq) const {
        typedef unsigned u32x2 __attribute__((ext_vector_type(2)));
        const int ch0 = u.pn * 128 + wc * 32 + 8 * fq;
#ifdef FFN_USE_SHFL
        const int lane = fr + 16 * fq;
        const int lm1 = (lane + 63) & 63, lp15 = (lane + 15) & 63, lp1 = (lane + 1) & 63, lm15 = (lane + 49) & 63;
#endif
        const int T = tile0 + u.pm;
        const bool isctx = T < 5;
#pragma unroll
        for (int n = 0; n < 2; ++n) {
            f32x4 w0[2], w1[2], w2[2], bb[2];
#pragma unroll
            for (int h = 0; h < 2; ++h) { const int col = h * 2816 + ch0 + 4 * n;
                w0[h] = *(const f32x4*)(cw + col); w1[h] = *(const f32x4*)(cw + 5632 + col); w2[h] = *(const f32x4*)(cw + 2 * 5632 + col); bb[h] = *(const f32x4*)(cb + col); }
#pragma unroll
            for (int ai = 0; ai < 2; ++ai) {
                const int B = T * 4 + ai * 2 + wr;
                int orow0, tok0 = 0;
                if (isctx) { const int b = B / 5, blk = B - 5 * b; tok0 = 62 * blk - 1; orow0 = b * 256 + tok0; }
                else orow0 = 1024 + (T - 5) * 256 + ai * 128 + wr * 64;
#pragma unroll
                for (int m = 0; m < 4; ++m) {
                    f32x4 cv[2];
#pragma unroll
                    for (int h = 0; h < 2; ++h) {
                        f32x4 o;
#pragma unroll
                        for (int j = 0; j < 4; ++j) {
                            const float cur = acc[ai][h][m][n][j];
#ifdef FFN_USE_SHFL
                            const float pa = __shfl(cur, lm1);
                            const float pb = (m > 0) ? __shfl(acc[ai][h][m > 0 ? m - 1 : 0][n][j], lp15) : 0.f;
                            const float na = __shfl(cur, lp1);
                            const float nb = (m < 3) ? __shfl(acc[ai][h][m < 3 ? m + 1 : 3][n][j], lm15) : 0.f;
                            const float prev = fr > 0 ? pa : pb, next = fr < 15 ? na : nb;
#else
                            const float prev = dpp_prev(cur, acc[ai][h][m > 0 ? m - 1 : 0][n][j], m > 0);
                            const float next = dpp_next(cur, acc[ai][h][m < 3 ? m + 1 : 3][n][j], m < 3);
#endif
                            o[j] = bb[h][j] + w0[h][j] * prev + w1[h][j] * cur + w2[h][j] * next;
                        }
                        cv[h] = o;
                    }
                    const int i = 16 * m + fr;
                    bool valid = true;
                    if (isctx) valid = (i >= 1) && (i <= 62) && (tok0 + i < 256);
                    float o[4];
#pragma unroll
                    for (int j = 0; j < 4; ++j) { const float g = cv[0][j], v = cv[1][j]; o[j] = g * sigmoidf_(g) * v; }
                    u32x2 w; w.x = cvt_pk_bf16(o[0], o[1]); w.y = cvt_pk_bf16(o[2], o[3]);
                    if (valid) *(u32x2*)(H + (size_t)(orow0 + i) * 2816 + ch0 + 4 * n) = w;
                }
            }
        }
    }
};

template <class Epi, class Sched, bool ALIGN_EPI = false, bool SP2 = false>
__device__ __forceinline__ void gemm_phase(PG8_LAS unsigned char* lds, const Gemm g, const Sched& S, const Epi& E, const int tid_in) {
    const int tid = tid_in, wid = __builtin_amdgcn_readfirstlane(tid >> 6), lane = tid & 63, wr = wid >> 2, wc = wid & 3, fr = lane & 15, fq = lane >> 4;
    const int K = g.K, nt = K / BK;
    unsigned voffA[2], voffB[2];
#pragma unroll
    for (int i = 0; i < 2; ++i) { int R, C; stage_rc(tid * 16 + i * 8192, R, C); const int Rb = Epi::PERM ? ((R & ~31) + perm32(R & 31)) : R;
        voffA[i] = (unsigned)(R * K + C) * 2u; voffB[i] = (unsigned)(Rb * K + C) * 2u; }
    const size_t kstep = (size_t)(BK * 2);
    const size_t hstep = (size_t)HALF * K * 2;
    const size_t tstep = 2 * hstep;
    const unsigned ldsw = (unsigned)wid * 1024u;
    const int aoff = lds_byte(wr * 64 + fr, fq * 8), boff = lds_byte(wc * 32 + fr, fq * 8);
#define PG8_SA(b, h) (((b) * 2 + (h)) * HTB)
#define PG8_SB(b, h) ((4 + (b) * 2 + (h)) * HTB)
#define PG8_STAGE(bufoff, gbase, voff) do { _Pragma("unroll") for (int _i = 0; _i < 2; ++_i) \
        __builtin_amdgcn_global_load_lds((const unsigned*)((const char*)(gbase) + (voff)[_i]), (PG8_LAS unsigned*)(lds + (bufoff) + ldsw + _i * 8192), 16, 0, 0); } while (0)
#define PG8_LDA(dst, b, h) do { _Pragma("unroll") for (int m = 0; m < 4; ++m) _Pragma("unroll") for (int k = 0; k < 2; ++k) dst[m][k] = *(const PG8_LAS bf16x8*)(lds + PG8_SA(b, h) + aoff + m * 2048 + k * 1024); } while (0)
#define PG8_LDB(dst, b, h) do { _Pragma("unroll") for (int n = 0; n < 2; ++n) _Pragma("unroll") for (int k = 0; k < 2; ++k) dst[n][k] = *(const PG8_LAS bf16x8*)(lds + PG8_SB(b, h) + boff + n * 2048 + k * 1024); } while (0)
#define PG8_MMA(ai, bj, At, Bt) do { __builtin_amdgcn_s_setprio(1); _Pragma("unroll") for (int m = 0; m < 4; ++m) _Pragma("unroll") for (int n = 0; n < 2; ++n) _Pragma("unroll") for (int k = 0; k < 2; ++k) \
        acc[ai][bj][m][n] = __builtin_amdgcn_mfma_f32_16x16x32_bf16(Bt[n][k], At[m][k], acc[ai][bj][m][n], 0, 0, 0); __builtin_amdgcn_s_setprio(0); } while (0)
#define PG8_WAIT_V(n) asm volatile("s_waitcnt vmcnt(" #n ")" ::: "memory")
#define PG8_WAIT_L(n) asm volatile("s_waitcnt lgkmcnt(" #n ")" ::: "memory")
#define PG8_BAR __builtin_amdgcn_s_barrier()
#define PG8_SCHED __builtin_amdgcn_sched_barrier(0)
    Unit cur, nxt; int ui = 0;
    if (!S.next(0, cur)) return;
    f32x4 acc[2][2][4][2];
#pragma unroll
    for (int a = 0; a < 2; ++a)
#pragma unroll
        for (int b = 0; b < 2; ++b)
#pragma unroll
            for (int m = 0; m < 4; ++m)
#pragma unroll
                for (int n = 0; n < 2; ++n) acc[a][b][m][n] = (f32x4){0.f, 0.f, 0.f, 0.f};
    bf16x8 At[4][2], B0[2][2], B1[2][2];
    const char* cA = (const char*)g.A + (size_t)cur.pm * tstep; const char* cB = (const char*)g.Bt + (size_t)cur.pn * tstep;
    S.a_ready(cur);
    if constexpr (SP2) {
        PG8_STAGE(PG8_SB(0, 0), cB, voffB); PG8_STAGE(PG8_SB(0, 1), cB + hstep, voffB); PG8_STAGE(PG8_SA(0, 0), cA, voffA); PG8_STAGE(PG8_SA(0, 1), cA + hstep, voffA);
        if (wr == 1) PG8_BAR;
        PG8_WAIT_V(2); PG8_BAR;
        PG8_STAGE(PG8_SB(1, 0), cB + kstep, voffB); PG8_STAGE(PG8_SA(1, 0), cA + kstep, voffA); PG8_STAGE(PG8_SB(1, 1), cB + hstep + kstep, voffB);
        PG8_WAIT_V(6); PG8_BAR;
    } else {
        PG8_STAGE(PG8_SB(0, 0), cB, voffB); PG8_STAGE(PG8_SA(0, 0), cA, voffA); PG8_STAGE(PG8_SB(0, 1), cB + hstep, voffB); PG8_STAGE(PG8_SA(0, 1), cA + hstep, voffA);
        if (wr == 1) PG8_BAR;
        PG8_WAIT_V(4); PG8_BAR;
        PG8_STAGE(PG8_SB(1, 0), cB + kstep, voffB); PG8_STAGE(PG8_SA(1, 0), cA + kstep, voffA); PG8_STAGE(PG8_SB(1, 1), cB + hstep + kstep, voffB);
        PG8_WAIT_V(6); PG8_BAR;
    }
    for (;;) {
        const bool has_next = S.next(ui + 1, nxt);
        const char* nA = has_next ? (const char*)g.A + (size_t)nxt.pm * tstep : cA; const char* nB = has_next ? (const char*)g.Bt + (size_t)nxt.pn * tstep : cB;
        for (int t = 0; t < nt; t += 2) {
            const bool last = (t == nt - 2);
            const char* a1 = cA + (size_t)(t + 1) * kstep;
            const char* a2 = last ? nA : cA + (size_t)(t + 2) * kstep; const char* b2 = last ? nB : cB + (size_t)(t + 2) * kstep;
            const char* a3 = a2 + kstep; const char* b3 = b2 + kstep;
            if (last && has_next) S.a_ready(nxt);
            if constexpr (SP2) {
            PG8_LDB(B0, 0, 0); PG8_LDB(B1, 0, 1); PG8_SCHED; PG8_LDA(At, 0, 0); PG8_STAGE(PG8_SA(1, 1), a1 + hstep, voffA);
            PG8_WAIT_V(8); PG8_WAIT_L(0); PG8_BAR; PG8_MMA(0, 0, At, B0); PG8_MMA(0, 1, At, B1); PG8_BAR; PG8_SCHED;
            PG8_LDA(At, 0, 1); PG8_STAGE(PG8_SB(0, 0), b2, voffB); PG8_STAGE(PG8_SB(0, 1), b2 + hstep, voffB); PG8_STAGE(PG8_SA(0, 0), a2, voffA);
            PG8_WAIT_V(8); PG8_WAIT_L(0); PG8_BAR; PG8_MMA(1, 0, At, B0); PG8_MMA(1, 1, At, B1); PG8_BAR; PG8_SCHED;
            PG8_LDB(B0, 1, 0); PG8_LDB(B1, 1, 1); PG8_SCHED; PG8_LDA(At, 1, 0); PG8_STAGE(PG8_SA(0, 1), a2 + hstep, voffA);
            PG8_WAIT_V(8); PG8_WAIT_L(0); PG8_BAR; PG8_MMA(0, 0, At, B0); PG8_MMA(0, 1, At, B1); PG8_BAR; PG8_SCHED;
            PG8_LDA(At, 1, 1); PG8_STAGE(PG8_SB(1, 0), b3, voffB); PG8_STAGE(PG8_SB(1, 1), b3 + hstep, voffB); PG8_STAGE(PG8_SA(1, 0), a3, voffA);
            PG8_WAIT_V(8); PG8_WAIT_L(0); PG8_BAR; PG8_MMA(1, 0, At, B0); PG8_MMA(1, 1, At, B1); PG8_BAR; PG8_SCHED;
            } else {
            PG8_LDB(B0, 0, 0); PG8_SCHED; PG8_LDA(At, 0, 0); PG8_STAGE(PG8_SA(1, 1), a1 + hstep, voffA);
            PG8_WAIT_L(8); PG8_BAR; PG8_WAIT_L(0); PG8_MMA(0, 0, At, B0); PG8_BAR; PG8_SCHED;
            PG8_LDB(B1, 0, 1); PG8_STAGE(PG8_SB(0, 0), b2, voffB);
            PG8_BAR; PG8_WAIT_L(0); PG8_MMA(0, 1, At, B1); PG8_BAR;
            PG8_LDA(At, 0, 1); PG8_STAGE(PG8_SA(0, 0), a2, voffA);
            PG8_BAR; PG8_WAIT_L(0); PG8_MMA(1, 0, At, B0); PG8_BAR; PG8_SCHED;
            PG8_STAGE(PG8_SB(0, 1), b2 + hstep, voffB);
            PG8_WAIT_V(6); PG8_BAR; PG8_MMA(1, 1, At, B1); PG8_BAR;
            PG8_LDB(B0, 1, 0); PG8_SCHED; PG8_LDA(At, 1, 0); PG8_STAGE(PG8_SA(0, 1), a2 + hstep, voffA);
            PG8_WAIT_L(8); PG8_BAR; PG8_WAIT_L(0); PG8_MMA(0, 0, At, B0); PG8_BAR; PG8_SCHED;
            PG8_LDB(B1, 1, 1); PG8_STAGE(PG8_SB(1, 0), b3, voffB);
            PG8_BAR; PG8_WAIT_L(0); PG8_MMA(0, 1, At, B1); PG8_BAR;
            PG8_LDA(At, 1, 1); PG8_STAGE(PG8_SA(1, 0), a3, voffA);
            PG8_BAR; PG8_WAIT_L(0); PG8_MMA(1, 0, At, B0); PG8_BAR; PG8_SCHED;
            PG8_STAGE(PG8_SB(1, 1), b3 + hstep, voffB);
            PG8_WAIT_V(6); PG8_BAR; PG8_MMA(1, 1, At, B1); PG8_BAR;
            }
        }
        if constexpr (ALIGN_EPI) { if (wr == 0) PG8_BAR; }
        if constexpr (!Epi::AFTER_DRAIN) { E(acc, cur, wr, wc, fr, fq); S.done(cur); }
        if (!has_next) break;
#pragma unroll
        for (int a = 0; a < 2; ++a)
#pragma unroll
            for (int b = 0; b < 2; ++b)
#pragma unroll
                for (int m = 0; m < 4; ++m)
#pragma unroll
                    for (int n = 0; n < 2; ++n) acc[a][b][m][n] = (f32x4){0.f, 0.f, 0.f, 0.f};
        cur = nxt; cA = nA; cB = nB; ++ui;
        if constexpr (ALIGN_EPI) { if (wr == 1) PG8_BAR; }
    }
    PG8_WAIT_V(0);
    if constexpr (!ALIGN_EPI) { if (wr == 0) PG8_BAR; }
    PG8_BAR;
    if constexpr (Epi::AFTER_DRAIN) { E.fused(acc, cur, wr, wc, fr, fq, lds, wid, lane); S.done(cur); }
#undef PG8_SA
#undef PG8_SB
#undef PG8_STAGE
#undef PG8_LDA
#undef PG8_LDB
#undef PG8_MMA
#undef PG8_WAIT_V
#undef PG8_WAIT_L
#undef PG8_BAR
#undef PG8_SCHED
}
}
#ifndef S5_VALU_MASK
#define S5_VALU_MASK 0
#endif
constexpr int NWAVES = 8, NTHR = 512;
constexpr int DM = 1024, NB = 4, SEQ = 4096, CTXL = 256, DEPTH = 2;
constexpr int RC = NB * CTXL, RL = NB * SEQ, RT = RC + RL;
constexpr int RH = 1280 + RL;
constexpr int DSSD = 512, NHEAD = 8, HD = 64, NGRP = 2, HPG = 4, NST = 128, QCH = 128;
constexpr int DS5 = 512, S5C = 16, S5G = 32, S5P = 64;
constexpr int DFF = 2816, XBC = 1024, DPROJ = 2064, NZXU = 2048;
constexpr int NSLOT = 34, NSLOT5 = 68;
constexpr float EPS = 1e-6f;
enum { I_X = 0, I_C, I_CTX, I_CCTX, I_WADA, I_BADA, I_GPREMIX, I_GPOSTMIX, I_GPREFFN, I_GPOSTFFN, I_WIN, I_SCONVW, I_SCONVB, I_DTBIAS, I_ALOG, I_SSDD, I_SNORMG,
       I_ARE, I_AIM, I_LOGDT, I_BRE, I_BIM, I_CRE, I_CIM, I_S5D, I_GLUW, I_GLUB, I_WOUT, I_WUP, I_FCONVW, I_FCONVB, I_WDOWN, N_IN };
constexpr size_t KiB = 1024, MiB = 1u << 20;
constexpr size_t WS_CTL = 0, CTL_ZERO_BYTES = 64 * KiB;
constexpr size_t WS_ADA = 1 * MiB;
constexpr size_t WS_LAMB = 1 * MiB + 512 * KiB;
constexpr size_t WS_LAMQ = WS_LAMB + 64 * KiB;
constexpr size_t WS_CMAT = WS_LAMQ + 64 * KiB;
constexpr size_t WS_BBAR = 2 * MiB;
constexpr size_t WS_DT = 4 * MiB;
constexpr size_t WS_SSQ = 5 * MiB + 512 * KiB;
constexpr size_t WS_DEC = 5 * MiB + 768 * KiB;
constexpr size_t WS_S5ST = 6 * MiB;
constexpr size_t WS_CTXX = 15 * MiB;
constexpr size_t WS_WIN = 19 * MiB, WS_WGLU = 23 * MiB, WS_WOUT = 23 * MiB + 512 * KiB, WS_WUP = 25 * MiB + 512 * KiB, WS_WDOWN = 36 * MiB + 512 * KiB;
constexpr size_t WS_A = 42 * MiB;
constexpr size_t WS_MIX = 110 * MiB;
constexpr size_t WS_G = 144 * MiB;
constexpr size_t WS_ZXU = 161 * MiB;
constexpr size_t WS_HACT = 80 * MiB;
constexpr size_t WS_FOUT = 174 * MiB;
constexpr size_t WS_BBARF = 246 * MiB;
constexpr size_t WS_END = 247 * MiB;
constexpr int CW_BAR = 4096;
constexpr int RING_BYTES = 131072;
constexpr int LDS_BYTES = 163840;
constexpr int LDSCTL_OFF = LDS_BYTES - 1024, MISC_OFF = LDSCTL_OFF + 320, PTAB_OFF = LDSCTL_OFF + 512;

#define GAS __attribute__((address_space(1)))
#define LAS __attribute__((address_space(3)))
typedef unsigned short bf16;
typedef unsigned v4u __attribute__((ext_vector_type(4)));
typedef unsigned v2u __attribute__((ext_vector_type(2)));
typedef float f32x4 __attribute__((ext_vector_type(4)));
typedef float f32x2 __attribute__((ext_vector_type(2)));
typedef short bf16x8 __attribute__((ext_vector_type(8)));
typedef GAS unsigned gu32;
#define RLX_AGENT __ATOMIC_RELAXED, __HIP_MEMORY_SCOPE_AGENT
#define LDS_WAIT() asm volatile("s_waitcnt lgkmcnt(0)" ::: "memory")
__device__ __forceinline__ unsigned f2bf(float f) { unsigned u = __builtin_bit_cast(unsigned, f); return (u + 0x7fffu + ((u >> 16) & 1u)) >> 16; }
__device__ __forceinline__ unsigned pk2(float lo, float hi) { return f2bf(lo) | (f2bf(hi) << 16); }
__device__ __forceinline__ float bf2f(unsigned h) { return __uint_as_float(h << 16); }
__device__ __forceinline__ float bflo(unsigned w) { return __uint_as_float(w << 16); }
__device__ __forceinline__ float bfhi(unsigned w) { return __uint_as_float(w & 0xffff0000u); }
__device__ __forceinline__ float siluf_(float x) { return x / (1.0f + __expf(-x)); }
#define XB_TMO      128
#define XB_XCNT(j)  (256  + 64 * (j))
#define XB_XSUB(j)  (1280 + 64 * (j))
#define XB_XGEN(j)  (2304 + 64 * (j))
#define XB_TOP      3328
#define XB_TOPGEN   3392
#define XCD_BAR_WORDS 3456
#define XB_SPIN_CAP (1u << 18)

__device__ __forceinline__ unsigned xb_ld(unsigned* p)              { return __hip_atomic_load(p, __ATOMIC_RELAXED, __HIP_MEMORY_SCOPE_AGENT); }
__device__ __forceinline__ unsigned xb_add(unsigned* p, unsigned v) { return __hip_atomic_fetch_add(p, v, __ATOMIC_RELAXED, __HIP_MEMORY_SCOPE_AGENT); }
__device__ __forceinline__ unsigned xb_xcc_id() { return (unsigned)__builtin_amdgcn_s_getreg((3 << 11) | 20) & 0xFu; }
#define XB_SPIN(cond, bar) do { unsigned _sp = 0; while (cond) { __builtin_amdgcn_s_sleep(1); \
    if ((++_sp & 255u) == 0u) { if (xb_ld(&(bar)[XB_TMO])) break; if (_sp > XB_SPIN_CAP) { atomicAdd(&(bar)[XB_TMO], 1u); break; } } } } while (0)

struct XcdBarrier {
    unsigned* bar; unsigned x;
    volatile LAS unsigned* st;
};

__device__ __forceinline__ XcdBarrier xcd_barrier_post(unsigned* bar, volatile LAS unsigned* st) {
    XcdBarrier b; b.bar = bar; b.x = xb_xcc_id(); b.st = st;
    if (threadIdx.x == 0) (void)xb_add(&bar[XB_XCNT(b.x)], 1u);
    return b;
}
__device__ __forceinline__ void xcd_barrier_complete(unsigned* bar, unsigned x, unsigned& nloc, unsigned& nx) {
    const unsigned G = gridDim.x * gridDim.y * gridDim.z;
    unsigned sum, cnt, mine, sp = 0u;
    for (;;) {
        sum = 0u; cnt = 0u; mine = 0u;
#pragma unroll
        for (unsigned j = 0; j < 16; ++j) { const unsigned c = xb_ld(&bar[XB_XCNT(j)]); sum += c; cnt += (c > 0u) ? 1u : 0u; mine = (j == x) ? c : mine; }
        if (sum == G) break;
        __builtin_amdgcn_s_sleep(1);
        if ((++sp & 255u) == 0u) { if (xb_ld(&bar[XB_TMO])) break; if (sp > XB_SPIN_CAP) { atomicAdd(&bar[XB_TMO], 1u); break; } }
    }
    nloc = mine > 0u ? mine : 1u; nx = cnt > 0u ? cnt : 1u;
}

__device__ __forceinline__ void xcd_barrier(const XcdBarrier& b) {
    asm volatile("s_waitcnt vmcnt(0)" ::: "memory");
    __syncthreads();
    if (threadIdx.x == 0) {
        unsigned* bar = b.bar;
        __builtin_amdgcn_s_waitcnt(0);
        unsigned nloc = b.st[0], nx = b.st[1];
        if (nloc == 0u) { xcd_barrier_complete(bar, b.x, nloc, nx); b.st[0] = nloc; b.st[1] = nx; }
        const unsigned old = xb_add(&bar[XB_XSUB(b.x)], 1u);
        const unsigned gen = old / nloc;
        if (old + 1u == (gen + 1u) * nloc) {
            __builtin_amdgcn_fence(__ATOMIC_RELEASE, "agent");
            asm volatile("s_waitcnt vmcnt(0)" ::: "memory");
            const unsigned og = xb_add(&bar[XB_TOP], 1u);
            const unsigned tg = og / nx;
            if (og + 1u == (tg + 1u) * nx) xb_add(&bar[XB_TOPGEN], 1u);
            else XB_SPIN(xb_ld(&bar[XB_TOPGEN]) == tg, bar);
            __builtin_amdgcn_fence(__ATOMIC_ACQUIRE, "agent");
            xb_add(&bar[XB_XGEN(b.x)], 1u);
            asm volatile("s_waitcnt vmcnt(0)" ::: "memory");
        } else {
            XB_SPIN(xb_ld(&bar[XB_XGEN(b.x)]) == gen, bar);
            __builtin_amdgcn_fence(__ATOMIC_ACQUIRE, "agent");
            asm volatile("s_waitcnt vmcnt(0)" ::: "memory");
        }
    }
    __syncthreads();
}
struct Frame {
    LAS unsigned char* lds;
    volatile LAS unsigned* MISC;
    gu32* ctl;
    int tid, lane, wave;
    int vcu, G;
    const LAS unsigned long long* ptab;
    float* out;
    unsigned char* ws;
};
#define INP(i) ((const float*)(GAS const float*)F.ptab[(i)])
__device__ __forceinline__ float wave_sum(float v) {
#pragma unroll
    for (int o = 1; o < 64; o <<= 1) v += __shfl_xor(v, o);
    return v;
}
__device__ __forceinline__ int row_batch(int r) { return r < RC ? (r >> 8) : ((r - RC) >> 12); }
__device__ __forceinline__ int row_modv(int r) { return r < RC ? 4 : ((r - RC) >> 12); }

__device__ __forceinline__ void p0_ada_tables(Frame& F) {
    LAS float* sc = (LAS float*)(F.lds);
    LAS float* red = sc + 5 * 1024;
    const float* cv = INP(I_C); const float* cc = INP(I_CCTX);
    for (int i = F.tid; i < 5120; i += NTHR) { const int v = i >> 10, k = i & 1023; const float c = v < 4 ? cv[v * 1024 + k] : cc[k]; sc[i] = c / (1.0f + expf(-c)); }
    __syncthreads();
    float* ada = (float*)(F.ws + WS_ADA);
    const float* wada = INP(I_WADA); const float* bada = INP(I_BADA);
    for (int unit = F.vcu; unit < 384; unit += F.G) {
        const int l = unit / 192, j0 = (unit % 192) * 32, col = F.tid & 31, kq = F.tid >> 5;
        float acc[5] = {0.f, 0.f, 0.f, 0.f, 0.f};
        const float* w = wada + (size_t)l * 1024 * 6144 + j0 + col;
#pragma unroll 8
        for (int k = kq; k < 1024; k += 16) { const float wv = w[(size_t)k * 6144];
#pragma unroll
            for (int v = 0; v < 5; ++v) acc[v] += sc[v * 1024 + k] * wv; }
#pragma unroll
        for (int v = 0; v < 5; ++v) red[(kq * 5 + v) * 32 + col] = acc[v];
        __syncthreads();
        if (F.tid < 160) { const int v = F.tid >> 5, c2 = F.tid & 31; float s = 0.f;
#pragma unroll
            for (int q = 0; q < 16; ++q) s += red[(q * 5 + v) * 32 + c2];
            ada[(l * 5 + v) * 6144 + j0 + c2] = s + bada[l * 6144 + j0 + c2]; }
        __syncthreads();
    }
    const int gt = F.vcu * NTHR + F.tid, GT = F.G * NTHR;
    f32x2* LAMB = (f32x2*)(F.ws + WS_LAMB); f32x2* LAMQ = (f32x2*)(F.ws + WS_LAMQ); bf16* BBT = (bf16*)(F.ws + WS_BBAR); bf16* CMAT = (bf16*)(F.ws + WS_CMAT);
    for (int idx = gt; idx < 2 * 2 * 32 * 64; idx += GT) {
        const int l = idx >> 12, dir = (idx >> 11) & 1, g = (idx >> 6) & 31, p = idx & 63;
        const double dtv = exp((double)INP(I_LOGDT)[(l * 2 + dir) * 32 + g]);
        const double are = (double)INP(I_ARE)[idx], aim = (double)INP(I_AIM)[idx];
        const double er = exp(are * dtv), lr = er * cos(aim * dtv), li = er * sin(aim * dtv);
        const double eq = exp(64.0 * are * dtv), qr = eq * cos(64.0 * aim * dtv), qi = eq * sin(64.0 * aim * dtv);
        const double nr = lr - 1.0, ni = li, den = are * are + aim * aim;
        const double cr = (nr * are + ni * aim) / den, ci = (ni * are - nr * aim) / den;
        LAMB[idx] = (f32x2){(float)lr, (float)li}; LAMQ[idx] = (f32x2){(float)qr, (float)qi};
        const float* bre = INP(I_BRE) + ((size_t)(l * 32 + g) * 64 + p) * 16; const float* bim = INP(I_BIM) + ((size_t)(l * 32 + g) * 64 + p) * 16;
        unsigned wre[8], wim[8];
#pragma unroll
        for (int c = 0; c < 16; c += 2) { const double br0 = bre[c], bi0 = bim[c], br1 = bre[c + 1], bi1 = bim[c + 1];
            wre[c >> 1] = pk2((float)(cr * br0 - ci * bi0), (float)(cr * br1 - ci * bi1)); wim[c >> 1] = pk2((float)(cr * bi0 + ci * br0), (float)(cr * bi1 + ci * br1)); }
        v4u* dst = (v4u*)(BBT + (size_t)idx * 32);
        dst[0] = (v4u){wre[0], wre[1], wre[2], wre[3]}; dst[1] = (v4u){wre[4], wre[5], wre[6], wre[7]};
        dst[2] = (v4u){wim[0], wim[1], wim[2], wim[3]}; dst[3] = (v4u){wim[4], wim[5], wim[6], wim[7]};
    }
    for (int idx = gt; idx < 2 * 32 * 16 * 64; idx += GT) {
        const int p = idx & 63, lgc = idx >> 6;
        const float cre = INP(I_CRE)[idx], cim = INP(I_CIM)[idx];
        *(unsigned*)(CMAT + (size_t)lgc * 128 + 2 * p) = pk2(cre, -cim);
    }
}
__device__ __forceinline__ void transpose_item(const float* W, int ldw, int k0, int nsrc0, bf16* WT, int K, int ndst0, LAS float* scr, int lane) {
#pragma unroll 8
    for (int i = 0; i < 32; ++i) { const int kk = 2 * i + (lane >> 5); scr[kk * 33 + (lane & 31)] = W[(size_t)(k0 + kk) * ldw + nsrc0 + (lane & 31)]; }
    LDS_WAIT(); asm volatile("" ::: "memory");
    const int c = lane & 7;
#pragma unroll
    for (int j = 0; j < 4; ++j) { const int n = (lane >> 3) + 8 * j; const LAS float* s = scr + (8 * c) * 33 + n;
        v4u o; o.x = pk2(s[0 * 33], s[1 * 33]); o.y = pk2(s[2 * 33], s[3 * 33]); o.z = pk2(s[4 * 33], s[5 * 33]); o.w = pk2(s[6 * 33], s[7 * 33]);
        *(GAS v4u*)(WT + (size_t)(ndst0 + n) * K + k0 + 8 * c) = o; }
    LDS_WAIT(); asm volatile("" ::: "memory");
}
__device__ __forceinline__ void convert_weights(Frame& F, int l, int lds_off) {
    LAS float* scr = (LAS float*)(F.lds + lds_off + F.wave * 8448);
    const int gw = F.vcu * NWAVES + F.wave, NGW = F.G * NWAVES;
    constexpr int I_IN = 16 * 64, I_GL = 8 * 16, I_OUT = 16 * 32, I_UP = 16 * 176, I_DN = 44 * 32;
    constexpr int NIT = I_IN + I_GL + I_OUT + I_UP + I_DN;
    const float* win = INP(I_WIN) + (size_t)l * 1024 * DPROJ; const float* wglu = INP(I_GLUW) + (size_t)l * 512 * 512; const float* wout = INP(I_WOUT) + (size_t)l * 1024 * 1024;
    const float* wup = INP(I_WUP) + (size_t)l * 1024 * 5632; const float* wdn = INP(I_WDOWN) + (size_t)l * 2816 * 1024;
    for (int it = gw; it < NIT; it += NGW) {
        int r = it;
        if (r < I_IN) { const int kb = r >> 6, nb = r & 63, d0 = nb * 32, s0 = d0 < 1536 ? d0 : d0 + 16; transpose_item(win, DPROJ, kb * 64, s0, (bf16*)(F.ws + WS_WIN), 1024, d0, scr, F.lane); continue; } r -= I_IN;
        if (r < I_GL) { const int kb = r >> 4, nb = r & 15; transpose_item(wglu, 512, kb * 64, nb * 32, (bf16*)(F.ws + WS_WGLU), 512, nb * 32, scr, F.lane); continue; } r -= I_GL;
        if (r < I_OUT) { const int kb = r >> 5, nb = r & 31; transpose_item(wout, 1024, kb * 64, nb * 32, (bf16*)(F.ws + WS_WOUT), 1024, nb * 32, scr, F.lane); continue; } r -= I_OUT;
        if (r < I_UP) { const int kb = r / 176, nb = r % 176, d0 = nb * 32, pn = d0 >> 8, h = (d0 >> 7) & 1, j = d0 & 127, s0 = h * 2816 + 128 * pn + j;
            transpose_item(wup, 5632, kb * 64, s0, (bf16*)(F.ws + WS_WUP), 1024, d0, scr, F.lane); continue; } r -= I_UP;
        { const int kb = r >> 5, nb = r & 31; transpose_item(wdn, 1024, kb * 64, nb * 32, (bf16*)(F.ws + WS_WDOWN), 2816, nb * 32, scr, F.lane); }
    }
}
__device__ __forceinline__ float softplusf_(float x) { return x > 20.f ? x : log1pf(expf(x)); }
__device__ __forceinline__ void stage_wdt(Frame& F, int l) {
    LAS float* wdt = (LAS float*)F.lds;
    const float* win = INP(I_WIN) + (size_t)l * 1024 * DPROJ + 1536;
    for (int i = F.tid; i < 1024 * 4; i += NTHR) { const int k = i >> 2, q = i & 3; *(LAS f32x4*)(wdt + k * 16 + (k >> 2) * 4 + 4 * q) = *(const f32x4*)(win + (size_t)k * DPROJ + 4 * q); }
    __syncthreads();
}
__device__ __forceinline__ void norm1_row(Frame& F, int l, int r, const f32x4 (&xv)[4]) {
    const float* ada = (const float*)(F.ws + WS_ADA) + (size_t)(l * 5 + row_modv(r)) * 6144;
    const float* gp = INP(I_GPREMIX) + l * 1024;
    float ss = 0.f;
#pragma unroll
    for (int j = 0; j < 4; ++j) ss += (xv[j].x * xv[j].x + xv[j].y * xv[j].y) + (xv[j].z * xv[j].z + xv[j].w * xv[j].w);
    const float rstd = rsqrtf(wave_sum(ss) * (1.f / 1024.f) + EPS);
    f32x4 h[4];
    bf16* HX = (bf16*)(F.ws + WS_A) + (size_t)r * 1024;
#pragma unroll
    for (int j = 0; j < 4; ++j) { const int c = 4 * F.lane + 256 * j;
        const f32x4 g = *(const f32x4*)(gp + c), sh = *(const f32x4*)(ada + c), scl = *(const f32x4*)(ada + 1024 + c);
        h[j] = (xv[j] * rstd * g) * (scl + 1.0f) + sh;
        v2u o; o.x = pk2(h[j].x, h[j].y); o.y = pk2(h[j].z, h[j].w); *(v2u*)(HX + c) = o; }
    const LAS float* wdt = (const LAS float*)F.lds;
    float acc[16];
#pragma unroll
    for (int q = 0; q < 16; ++q) acc[q] = 0.f;
#pragma unroll
    for (int j = 0; j < 4; ++j) {
#pragma unroll
        for (int i = 0; i < 4; ++i) { const int k = 4 * F.lane + 256 * j + i; const float hv = h[j][i];
#pragma unroll
            for (int q4 = 0; q4 < 4; ++q4) { const f32x4 w = *(const LAS f32x4*)(wdt + k * 16 + (k >> 2) * 4 + 4 * q4);
                acc[4 * q4 + 0] += hv * w.x; acc[4 * q4 + 1] += hv * w.y; acc[4 * q4 + 2] += hv * w.z; acc[4 * q4 + 3] += hv * w.w; }
            asm volatile("" ::: "memory"); }
    }
    float mine = 0.f;
#pragma unroll
    for (int q = 0; q < 16; ++q) { const float s = wave_sum(acc[q]); if (F.lane == q) mine = s; }
    if (F.lane < 16) ((float*)(F.ws + WS_DT))[(size_t)r * 16 + F.lane] = softplusf_(mine + INP(I_DTBIAS)[l * 16 + F.lane]);
}
__device__ __forceinline__ void p1_norm1_first(Frame& F) {
    stage_wdt(F, 0);
    const int gw = F.vcu * NWAVES + F.wave, NGW = F.G * NWAVES;
    for (int r = gw; r < RT; r += NGW) {
        const float* xr = r < RC ? INP(I_CTX) + (size_t)r * 1024 : INP(I_X) + (size_t)(r - RC) * 1024;
        f32x4 xv[4];
#pragma unroll
        for (int j = 0; j < 4; ++j) xv[j] = *(const f32x4*)(xr + 4 * F.lane + 256 * j);
        norm1_row(F, 0, r, xv);
    }
}
__device__ __forceinline__ void rms_row(const f32x4 (&xv)[4], const float* g, int lane, f32x4 (&o)[4]) {
    float ss = 0.f;
#pragma unroll
    for (int j = 0; j < 4; ++j) ss += (xv[j].x * xv[j].x + xv[j].y * xv[j].y) + (xv[j].z * xv[j].z + xv[j].w * xv[j].w);
    const float rstd = rsqrtf(wave_sum(ss) * (1.f / 1024.f) + EPS);
#pragma unroll
    for (int j = 0; j < 4; ++j) o[j] = xv[j] * rstd * *(const f32x4*)(g + 4 * lane + 256 * j);
}
__device__ __forceinline__ const float* xsrc_row(Frame& F, int l, bool after_mix, int r) {
    if (l == 0 && !after_mix) return r < RC ? INP(I_CTX) + (size_t)r * 1024 : INP(I_X) + (size_t)(r - RC) * 1024;
    return r < RC ? (const float*)(F.ws + WS_CTXX) + (size_t)r * 1024 : F.out + (size_t)(r - RC) * 1024;
}
__device__ __forceinline__ float* xdst_row(Frame& F, int r) { return r < RC ? (float*)(F.ws + WS_CTXX) + (size_t)r * 1024 : F.out + (size_t)(r - RC) * 1024; }
__device__ __forceinline__ void p8_postmix(Frame& F, int l, int r_lo) {
    const int gw = F.vcu * NWAVES + F.wave, NGW = F.G * NWAVES;
    bf16* HX2 = (bf16*)(F.ws + WS_A);
    if (r_lo == 0) {
        for (int a = gw; a < 1280; a += NGW) { const int w = a % 320, blk = w >> 6, i = w & 63, tok = 62 * blk - 1 + i;
            if (tok < 0 || tok >= 256) { v4u z = {0u, 0u, 0u, 0u}; *(v4u*)(HX2 + (size_t)a * 1024 + 8 * F.lane) = z; *(v4u*)(HX2 + (size_t)a * 1024 + 512 + 8 * F.lane) = z; } }
    }
    for (int r = r_lo + gw; r < RT; r += NGW) {
        const float* ada = (const float*)(F.ws + WS_ADA) + (size_t)(l * 5 + row_modv(r)) * 6144;
        const float* xm = (const float*)(F.ws + WS_ZXU) + (size_t)r * 1024;
        const float* xr = xsrc_row(F, l, false, r);
        f32x4 mv[4], xv[4], nm[4];
#pragma unroll
        for (int j = 0; j < 4; ++j) { mv[j] = *(const f32x4*)(xm + 4 * F.lane + 256 * j); xv[j] = *(const f32x4*)(xr + 4 * F.lane + 256 * j); }
        rms_row(mv, INP(I_GPOSTMIX) + l * 1024, F.lane, nm);
        float* xo = xdst_row(F, r);
#pragma unroll
        for (int j = 0; j < 4; ++j) { const int c = 4 * F.lane + 256 * j; xv[j] = xv[j] + *(const f32x4*)(ada + 2 * 1024 + c) * nm[j]; *(f32x4*)(xo + c) = xv[j]; }
        rms_row(xv, INP(I_GPREFFN) + l * 1024, F.lane, nm);
        v2u o[4];
#pragma unroll
        for (int j = 0; j < 4; ++j) { const int c = 4 * F.lane + 256 * j; const f32x4 h = nm[j] * (*(const f32x4*)(ada + 4 * 1024 + c) + 1.0f) + *(const f32x4*)(ada + 3 * 1024 + c);
            o[j].x = pk2(h.x, h.y); o[j].y = pk2(h.z, h.w); }
        if (r >= RC) {
#pragma unroll
            for (int j = 0; j < 4; ++j) *(v2u*)(HX2 + (size_t)(1280 + r - RC) * 1024 + 4 * F.lane + 256 * j) = o[j];
        } else {
            const int b = r >> 8, t = r & 255;
            const int blk1 = t / 62;
            { const int a = b * 320 + blk1 * 64 + (t + 1 - 62 * blk1);
#pragma unroll
              for (int j = 0; j < 4; ++j) *(v2u*)(HX2 + (size_t)a * 1024 + 4 * F.lane + 256 * j) = o[j]; }
            const int i1 = t + 1 - 62 * blk1;
            if (i1 == 1 && blk1 > 0) { const int a = b * 320 + (blk1 - 1) * 64 + 63;
#pragma unroll
              for (int j = 0; j < 4; ++j) *(v2u*)(HX2 + (size_t)a * 1024 + 4 * F.lane + 256 * j) = o[j]; }
            if (i1 == 62 && blk1 < 4) { const int a = b * 320 + (blk1 + 1) * 64 + 0;
#pragma unroll
              for (int j = 0; j < 4; ++j) *(v2u*)(HX2 + (size_t)a * 1024 + 4 * F.lane + 256 * j) = o[j]; }
        }
    }
}
__device__ __forceinline__ void p11_postffn(Frame& F, int l, int r_lo) {
    if (l == 0) stage_wdt(F, 1);
    const int gw = F.vcu * NWAVES + F.wave, NGW = F.G * NWAVES;
    for (int r = r_lo + gw; r < RT; r += NGW) {
        const float* ada = (const float*)(F.ws + WS_ADA) + (size_t)(l * 5 + row_modv(r)) * 6144;
        const float* fo = (const float*)(F.ws + WS_FOUT) + (size_t)r * 1024;
        const float* xr = xsrc_row(F, l, true, r);
        f32x4 mv[4], xv[4], nm[4];
#pragma unroll
        for (int j = 0; j < 4; ++j) { mv[j] = *(const f32x4*)(fo + 4 * F.lane + 256 * j); xv[j] = *(const f32x4*)(xr + 4 * F.lane + 256 * j); }
        rms_row(mv, INP(I_GPOSTFFN) + l * 1024, F.lane, nm);
        float* xo = xdst_row(F, r);
#pragma unroll
        for (int j = 0; j < 4; ++j) { const int c = 4 * F.lane + 256 * j; xv[j] = xv[j] + *(const f32x4*)(ada + 5 * 1024 + c) * nm[j]; *(f32x4*)(xo + c) = xv[j]; }
        if (l == 0) norm1_row(F, 1, r, xv);
    }
}
__device__ __forceinline__ f32x4 mfma16(bf16x8 a, bf16x8 b, f32x4 c) { return __builtin_amdgcn_mfma_f32_16x16x32_bf16(a, b, c, 0, 0, 0); }
constexpr float LOG2E = 1.4426950408889634f;
struct ChunkInfo { int r0, b, slot; bool hp, hn; };
__device__ __forceinline__ ChunkInfo chunk_info(int cidx) {
    ChunkInfo c; c.r0 = cidx * 128;
    if (cidx < 8) { c.b = cidx >> 1; const int cp = cidx & 1; c.slot = cp; c.hp = cp > 0; c.hn = cp < 1; }
    else { const int k = cidx - 8; c.b = k >> 5; const int cp = k & 31; c.slot = 2 + cp; c.hp = cp > 0; c.hn = cp < 31; }
    return c;
}
template <int NCOLS>
__device__ __forceinline__ void load_conv_tile(Frame& F, int l, int r0, bool hp, bool hn, int c0, LAS bf16* dst, int ld) {
    const bf16* Z = (const bf16*)(F.ws + WS_ZXU);
    const float* cw = INP(I_SCONVW) + l * 3 * 1024; const float* cb = INP(I_SCONVB) + l * 1024;
    constexpr int CG = NCOLS / 8;
    for (int it = F.tid; it < 128 * CG; it += NTHR) {
        const int row = it / CG, cg = it % CG, ch = c0 + 8 * cg;
        const bf16* p = Z + (size_t)(r0 + row) * 2048 + 512 + ch;
        const v4u z4 = {0u, 0u, 0u, 0u};
        const v4u cur = *(const v4u*)p;
        const v4u prv = (row > 0 || hp) ? *(const v4u*)(p - 2048) : z4;
        const v4u nxt = (row < 127 || hn) ? *(const v4u*)(p + 2048) : z4;
        float o[8];
#pragma unroll
        for (int q = 0; q < 2; ++q) {
            const f32x4 w0 = *(const f32x4*)(cw + ch + 4 * q), w1 = *(const f32x4*)(cw + 1024 + ch + 4 * q), w2 = *(const f32x4*)(cw + 2048 + ch + 4 * q), bb = *(const f32x4*)(cb + ch + 4 * q);
            const unsigned pa = q == 0 ? prv.x : prv.z, pb = q == 0 ? prv.y : prv.w, ca = q == 0 ? cur.x : cur.z, cbb = q == 0 ? cur.y : cur.w, na = q == 0 ? nxt.x : nxt.z, nb = q == 0 ? nxt.y : nxt.w;
            o[4 * q + 0] = siluf_(bb.x + w0.x * bflo(pa) + w1.x * bflo(ca) + w2.x * bflo(na));
            o[4 * q + 1] = siluf_(bb.y + w0.y * bfhi(pa) + w1.y * bfhi(ca) + w2.y * bfhi(na));
            o[4 * q + 2] = siluf_(bb.z + w0.z * bflo(pb) + w1.z * bflo(cbb) + w2.z * bflo(nb));
            o[4 * q + 3] = siluf_(bb.w + w0.w * bfhi(pb) + w1.w * bfhi(cbb) + w2.w * bfhi(nb));
        }
        v4u w; w.x = pk2(o[0], o[1]); w.y = pk2(o[2], o[3]); w.z = pk2(o[4], o[5]); w.w = pk2(o[6], o[7]);
        *(LAS v4u*)(dst + row * ld + 8 * cg) = w;
    }
}
constexpr int XS_LD = 264, BS_LD = 136;
constexpr int L_XS = 0, L_BS = L_XS + 128 * XS_LD * 2, L_CS = L_BS + 128 * BS_LD * 2, L_ARR = L_CS + 128 * BS_LD * 2;
constexpr int L_SSQ = L_ARR + 6 * 2048;
static_assert(L_SSQ + 2048 <= 162816, "SSD LDS map");
__device__ __forceinline__ void ssd_decay_arrays(Frame& F, int l, int r0, int g) {
    LAS float* arr = (LAS float*)(F.lds + L_ARR);
    const float* DT = (const float*)(F.ws + WS_DT);
    for (int i = F.tid; i < 1024; i += NTHR) { const int j = i >> 3, de = i & 7, dir = de >> 2, e = de & 3;
        arr[(2 + dir) * 512 + e * 128 + j] = DT[(size_t)(r0 + j) * 16 + dir * 8 + 4 * g + e]; }
    __syncthreads();
    if (F.tid < 8) { const int dir = F.tid >> 2, e = F.tid & 3;
        const float a = -expf(INP(I_ALOG)[l * 16 + dir * 8 + 4 * g + e]) * LOG2E;
        LAS float* d = arr + (2 + dir) * 512 + e * 128; LAS float* c = arr + dir * 512 + e * 128;
        float s = 0.f;
        if (dir == 0) { for (int j = 0; j < 128; ++j) { s += d[j] * a; c[j] = s; } }
        else { for (int j = 127; j >= 0; --j) { s += d[j] * a; c[j] = s; } }
    }
    __syncthreads();
    for (int i = F.tid; i < 1024; i += NTHR) { const int j = i & 127, de = i >> 7, dir = de >> 2, e = de & 3;
        const LAS float* c = arr + dir * 512 + e * 128; const float tot = dir == 0 ? c[127] : c[0];
        arr[(4 + dir) * 512 + e * 128 + j] = arr[(2 + dir) * 512 + e * 128 + j] * exp2f(tot - c[j]); }
    __syncthreads();
}
__device__ __forceinline__ void ssd_states_item(Frame& F, int l, int cidx, int g) {
    const ChunkInfo ci = chunk_info(cidx);
    LAS bf16* xs = (LAS bf16*)(F.lds + L_XS); LAS bf16* Bs = (LAS bf16*)(F.lds + L_BS);
    LAS float* arr = (LAS float*)(F.lds + L_ARR);
    load_conv_tile<256>(F, l, ci.r0, ci.hp, ci.hn, 256 * g, xs, XS_LD);
    load_conv_tile<128>(F, l, ci.r0, ci.hp, ci.hn, 512 + 128 * g, Bs, BS_LD);
    ssd_decay_arrays(F, l, ci.r0, g);
    const int w = F.wave, lane = F.lane, lr = lane & 15, q = lane >> 4, e = w >> 1;
    float* ST = (float*)(F.ws + WS_A);
#pragma unroll 1
    for (int dir = 0; dir < 2; ++dir) {
        f32x4 acc[2][8];
#pragma unroll
        for (int rt = 0; rt < 2; ++rt)
#pragma unroll
            for (int nt = 0; nt < 8; ++nt) acc[rt][nt] = (f32x4){0.f, 0.f, 0.f, 0.f};
        const LAS float* wd = arr + (4 + dir) * 512 + e * 128;
#pragma unroll 1
        for (int kt = 0; kt < 4; ++kt) {
            const int j0 = 32 * kt + 8 * q;
            bf16x8 bfr[8];
#pragma unroll
            for (int nt = 0; nt < 8; ++nt)
#pragma unroll
                for (int jj = 0; jj < 8; ++jj) bfr[nt][jj] = (short)Bs[(j0 + jj) * BS_LD + 16 * nt + lr];
#pragma unroll
            for (int rt = 0; rt < 2; ++rt) {
                const int col = 32 * w + 16 * rt + lr;
                bf16x8 af;
#pragma unroll
                for (int jj = 0; jj < 8; ++jj) { const float xv = bf2f(xs[(j0 + jj) * XS_LD + col]); af[jj] = (short)f2bf(xv * wd[j0 + jj]); }
#pragma unroll
                for (int nt = 0; nt < 8; ++nt) acc[rt][nt] = mfma16(af, bfr[nt], acc[rt][nt]);
            }
        }
        float* st = ST + ((((size_t)ci.b * 2 + dir) * NSLOT + ci.slot) * 2 + g) * 32768;
#pragma unroll
        for (int rt = 0; rt < 2; ++rt)
#pragma unroll
            for (int nt = 0; nt < 8; ++nt)
#pragma unroll
                for (int rg = 0; rg < 4; ++rg) { const int row = 32 * w + 16 * rt + 4 * q + rg, col = 16 * nt + lr; st[row * 128 + col] = acc[rt][nt][rg]; }
    }
    if (F.tid < 8) { const int dir = F.tid >> 2, ee = F.tid & 3; const LAS float* c = arr + dir * 512 + ee * 128;
        ((float*)(F.ws + WS_DEC))[((((size_t)ci.b * 2 + dir) * NSLOT + ci.slot) * 2 + g) * 4 + ee] = exp2f(dir == 0 ? c[127] : c[0]); }
    __syncthreads();
}
__device__ __forceinline__ void ssd_out_item(Frame& F, int l, int cidx, int g) {
    const ChunkInfo ci = chunk_info(cidx);
    LAS bf16* xs = (LAS bf16*)(F.lds + L_XS); LAS bf16* Bs = (LAS bf16*)(F.lds + L_BS); LAS bf16* Cs = (LAS bf16*)(F.lds + L_CS);
    LAS float* arr = (LAS float*)(F.lds + L_ARR); LAS float* ssq = (LAS float*)(F.lds + L_SSQ);
    load_conv_tile<256>(F, l, ci.r0, ci.hp, ci.hn, 256 * g, xs, XS_LD);
    load_conv_tile<128>(F, l, ci.r0, ci.hp, ci.hn, 512 + 128 * g, Bs, BS_LD);
    load_conv_tile<128>(F, l, ci.r0, ci.hp, ci.hn, 768 + 128 * g, Cs, BS_LD);
    ssd_decay_arrays(F, l, ci.r0, g);
    const int w = F.wave, lane = F.lane, lr = lane & 15, q = lane >> 4;
    {
        f32x4 cacc[8];
#pragma unroll
        for (int jt = 0; jt < 8; ++jt) cacc[jt] = (f32x4){0.f, 0.f, 0.f, 0.f};
#pragma unroll
        for (int kt = 0; kt < 4; ++kt) {
            const bf16x8 a = *(const LAS bf16x8*)(Cs + (16 * w + lr) * BS_LD + 32 * kt + 8 * q);
#pragma unroll
            for (int jt = 0; jt < 8; ++jt) { const bf16x8 b = *(const LAS bf16x8*)(Bs + (16 * jt + lr) * BS_LD + 32 * kt + 8 * q); cacc[jt] = mfma16(a, b, cacc[jt]); }
        }
        __syncthreads();
#pragma unroll
        for (int jt = 0; jt < 8; ++jt)
#pragma unroll
            for (int rg = 0; rg < 4; ++rg) Bs[(16 * w + 4 * q + rg) * BS_LD + 16 * jt + lr] = (bf16)f2bf(cacc[jt][rg]);
        __syncthreads();
    }
    LAS bf16* cbs = Bs;
    const int e = w >> 1, mh = w & 1, head = 4 * g + e;
    const LAS float* cumf = arr + 0 * 512 + e * 128; const LAS float* crev = arr + 1 * 512 + e * 128; const LAS float* dtf = arr + 2 * 512 + e * 128; const LAS float* dtb = arr + 3 * 512 + e * 128;
    f32x4 acc[4][4];
#pragma unroll
    for (int mt = 0; mt < 4; ++mt)
#pragma unroll
        for (int pt = 0; pt < 4; ++pt) acc[mt][pt] = (f32x4){0.f, 0.f, 0.f, 0.f};
#pragma unroll 1
    for (int kt = 0; kt < 4; ++kt) {
        const int j0 = 32 * kt + 8 * q;
        bf16x8 bx[4];
#pragma unroll
        for (int pt = 0; pt < 4; ++pt)
#pragma unroll
            for (int jj = 0; jj < 8; ++jj) bx[pt][jj] = (short)xs[(j0 + jj) * XS_LD + 64 * e + 16 * pt + lr];
        float cfj[8], crj[8], dfj[8], dbj[8];
#pragma unroll
        for (int jj = 0; jj < 8; ++jj) { cfj[jj] = cumf[j0 + jj]; crj[jj] = crev[j0 + jj]; dfj[jj] = dtf[j0 + jj]; dbj[jj] = dtb[j0 + jj]; }
#pragma unroll
        for (int mt = 0; mt < 4; ++mt) {
            const int i = 16 * (4 * mh + mt) + lr;
            const float cfi = cumf[i], cri = crev[i];
            const bf16x8 cbv = *(const LAS bf16x8*)(cbs + i * BS_LD + j0);
            bf16x8 a;
#pragma unroll
            for (int jj = 0; jj < 8; ++jj) { const int j = j0 + jj;
                float Lw;
                if (j < i) Lw = exp2f(cfi - cfj[jj]) * dfj[jj];
                else if (j > i) Lw = exp2f(cri - crj[jj]) * dbj[jj];
                else Lw = dfj[jj] + dbj[jj];
                a[jj] = (short)f2bf(bf2f((unsigned short)cbv[jj]) * Lw); }
#pragma unroll
            for (int pt = 0; pt < 4; ++pt) acc[mt][pt] = mfma16(a, bx[pt], acc[mt][pt]);
        }
    }
    const float* ST = (const float*)(F.ws + WS_A);
#pragma unroll 1
    for (int dir = 0; dir < 2; ++dir) {
        const float* H = ST + ((((size_t)ci.b * 2 + dir) * NSLOT + ci.slot) * 2 + g) * 32768 + (size_t)(64 * e) * 128;
        const LAS float* cc = dir == 0 ? cumf : crev;
#pragma unroll 1
        for (int kt = 0; kt < 4; ++kt) {
            bf16x8 bh[4];
#pragma unroll
            for (int pt = 0; pt < 4; ++pt) { const float* hp = H + (size_t)(16 * pt + lr) * 128 + 32 * kt + 8 * q; const f32x4 h0 = *(const f32x4*)hp, h1 = *(const f32x4*)(hp + 4);
                bh[pt][0] = (short)f2bf(h0.x); bh[pt][1] = (short)f2bf(h0.y); bh[pt][2] = (short)f2bf(h0.z); bh[pt][3] = (short)f2bf(h0.w);
                bh[pt][4] = (short)f2bf(h1.x); bh[pt][5] = (short)f2bf(h1.y); bh[pt][6] = (short)f2bf(h1.z); bh[pt][7] = (short)f2bf(h1.w); }
#pragma unroll
            for (int mt = 0; mt < 4; ++mt) {
                const int i = 16 * (4 * mh + mt) + lr;
                const float sc = exp2f(cc[i]);
                const bf16x8 cv = *(const LAS bf16x8*)(Cs + i * BS_LD + 32 * kt + 8 * q);
                bf16x8 a;
#pragma unroll
                for (int jj = 0; jj < 8; ++jj) a[jj] = (short)f2bf(bf2f((unsigned short)cv[jj]) * sc);
#pragma unroll
                for (int pt = 0; pt < 4; ++pt) acc[mt][pt] = mfma16(a, bh[pt], acc[mt][pt]);
            }
        }
    }
    const float Dh = INP(I_SSDD)[l * 8 + head];
    const bf16* Z = (const bf16*)(F.ws + WS_ZXU); bf16* MIX = (bf16*)(F.ws + WS_MIX);
#pragma unroll
    for (int mt = 0; mt < 4; ++mt)
#pragma unroll
        for (int rg = 0; rg < 4; ++rg) {
            const int i = 16 * (4 * mh + mt) + 4 * q + rg;
            float s2 = 0.f;
#pragma unroll
            for (int pt = 0; pt < 4; ++pt) { const int p = 16 * pt + lr, col = 64 * head + p;
                const float y = acc[mt][pt][rg] + Dh * bf2f(xs[i * XS_LD + 64 * e + p]);
                const float z = bf2f(Z[(size_t)(ci.r0 + i) * 2048 + col]);
                const float v = y * siluf_(z);
                s2 += v * v;
                MIX[(size_t)(ci.r0 + i) * 1024 + col] = (bf16)f2bf(v); }
            s2 += __shfl_xor(s2, 1); s2 += __shfl_xor(s2, 2); s2 += __shfl_xor(s2, 4); s2 += __shfl_xor(s2, 8);
            if (lr == 0) ssq[e * 128 + i] = s2;
        }
    __syncthreads();
    if (F.tid < 128) ((float*)(F.ws + WS_SSQ))[(size_t)(ci.r0 + F.tid) * 2 + g] = (ssq[F.tid] + ssq[128 + F.tid]) + (ssq[256 + F.tid] + ssq[384 + F.tid]);
    __syncthreads();
}
template <int DIR>
__device__ __forceinline__ void ssd_scan_lane(float* __restrict__ ST, const float* __restrict__ DEC, int b, int g, int ep, int n4) {
    const size_t base = (((size_t)b * 2 + DIR) * NSLOT) * 2 * 32768 + (size_t)g * 32768 + (size_t)ep * 128 + 4 * n4;
    const size_t dbase = (((size_t)b * 2 + DIR) * NSLOT) * 8 + g * 4 + (ep >> 6);
    f32x4 h = {0.f, 0.f, 0.f, 0.f};
#pragma unroll
    for (int half = 0; half < 2; ++half) {
        f32x4 s[17]; float d[17];
#pragma unroll
        for (int k = 0; k < 17; ++k) { const int kk = 17 * half + k; const int slot = DIR == 0 ? kk : (kk == 0 ? 1 : (kk == 1 ? 0 : NSLOT + 1 - kk));
            s[k] = *(const f32x4*)(ST + base + (size_t)slot * 65536); d[k] = DEC[dbase + slot * 8]; }
#pragma unroll
        for (int k = 0; k < 17; ++k) { const int kk = 17 * half + k; const int slot = DIR == 0 ? kk : (kk == 0 ? 1 : (kk == 1 ? 0 : NSLOT + 1 - kk));
            *(f32x4*)(ST + base + (size_t)slot * 65536) = h; h = h * d[k] + s[k]; }
    }
}
__device__ __forceinline__ void p4_scans(Frame& F, int l) {
    float* ST = (float*)(F.ws + WS_A); const float* DEC = (const float*)(F.ws + WS_DEC);
    const int gt = F.vcu * NTHR + F.tid, GT = F.G * NTHR;
    for (int idx = gt; idx < 4 * 2 * 2 * 256 * 32; idx += GT) {
        const int n4 = idx & 31, ep = (idx >> 5) & 255, g = (idx >> 13) & 1, dir = (idx >> 14) & 1, b = idx >> 15;
        if (dir == 0) ssd_scan_lane<0>(ST, DEC, b, g, ep, n4); else ssd_scan_lane<1>(ST, DEC, b, g, ep, n4);
    }
    f32x2* S5 = (f32x2*)(F.ws + WS_S5ST); const f32x2* LAMQ = (const f32x2*)(F.ws + WS_LAMQ);
    for (int idx = gt; idx < 4 * 2 * 2048; idx += GT) {
        const int gp = idx & 2047, dir = (idx >> 11) & 1, b = idx >> 12;
        const f32x2 lq = LAMQ[(l * 2 + dir) * 2048 + gp];
        f32x2* base = S5 + (((size_t)b * 2 + dir) * NSLOT5) * 2048 + gp;
        f32x2 h = {0.f, 0.f};
#pragma unroll 1
        for (int part = 0; part < 4; ++part) {
            f32x2 s[17];
#pragma unroll
            for (int k = 0; k < 17; ++k) { const int kk = 17 * part + k; const int slot = dir == 0 ? kk : (kk < 4 ? 3 - kk : NSLOT5 + 3 - kk); s[k] = base[(size_t)slot * 2048]; }
#pragma unroll
            for (int k = 0; k < 17; ++k) { const int kk = 17 * part + k; const int slot = dir == 0 ? kk : (kk < 4 ? 3 - kk : NSLOT5 + 3 - kk);
                base[(size_t)slot * 2048] = h; h = (f32x2){lq.x * h.x - lq.y * h.y + s[k].x, lq.x * h.y + lq.y * h.x + s[k].y}; }
        }
    }
}
__device__ __forceinline__ int s5_row0(int b, int n64) { return n64 < 4 ? b * 256 + 64 * n64 : RC + b * 4096 + 64 * (n64 - 4); }
__device__ __forceinline__ float gelu_tanh(float x) { const float u = 0.7978845608028654f * (x + 0.044715f * x * x * x); return 0.5f * x * (1.0f + tanhf(u)); }
constexpr int S5_UNITS = 17 * 32;
template <bool OUT>
__device__ __forceinline__ void s5_unit(Frame& F, int l, int unit, bool last, LAS unsigned char* wl) {
    const int g = unit & 31, cg = unit >> 5;
    const int lr = F.lane & 15, q = F.lane >> 4;
    const int c16 = 16 * cg + lr, b = c16 / NSLOT5, n64 = c16 - b * NSLOT5;
    const int r0 = s5_row0(b, n64);
    const bool skip_out = last && n64 < 4;
    const bf16* zrow = (const bf16*)(F.ws + WS_ZXU) + (size_t)r0 * 2048 + 1536 + 16 * g;
    f32x2* S5 = (f32x2*)(F.ws + WS_S5ST);
    bf16* PART = (bf16*)(F.ws + WS_MIX) + (size_t)r0 * 1024 + 512 + 16 * g + 4 * q;
    bf16* GO = (bf16*)(F.ws + WS_G) + (size_t)r0 * 512 + 16 * g + 4 * q;
    const bf16x8 zero8 = {0, 0, 0, 0, 0, 0, 0, 0};
    f32x4 dsk = {0.f, 0.f, 0.f, 0.f};
    if constexpr (OUT) {
        const bf16* CM = (const bf16*)(F.ws + WS_CMAT) + ((size_t)(l * 32 + g) * 16 + lr) * 128;
#pragma unroll
        for (int kt = 0; kt < 4; ++kt) { const v2u lo = *(const v2u*)(CM + 32 * kt + 4 * q), hi = *(const v2u*)(CM + 32 * kt + 16 + 4 * q);
            v4u w = {lo.x, lo.y, hi.x, hi.y}; ((LAS bf16x8*)wl + 512 + F.lane)[kt * 64] = __builtin_bit_cast(bf16x8, w); }
        dsk = *(const f32x4*)(INP(I_S5D) + l * 512 + 16 * g + 4 * q);
    }
#pragma unroll 1
    for (int dir = 0; dir < 2; ++dir) {
        const int ldg = (l * 2 + dir) * 32 + g;
        const bf16* BBT = (const bf16*)(F.ws + WS_BBAR) + (size_t)ldg * 128 * 16;
        f32x4 lam[8], h[8];
        LAS bf16x8* bfl = (LAS bf16x8*)wl + F.lane;
#pragma unroll
        for (int tl = 0; tl < 8; ++tl) { const bf16x8 v = *(const bf16x8*)(BBT + (16 * tl + lr) * 16 + 8 * (q & 1));
            bf16x8 vv;
#pragma unroll
            for (int j = 0; j < 8; ++j) vv[j] = q < 2 ? v[j] : (short)0;
            bfl[tl * 64] = vv;
            lam[tl] = *(const f32x4*)((const float*)(F.ws + WS_LAMB) + ((size_t)ldg * 64 + 8 * tl + 2 * q) * 2);
            if constexpr (OUT) h[tl] = *(const f32x4*)((const float*)(S5 + (((size_t)b * 2 + dir) * NSLOT5 + n64) * 2048 + g * 64 + 8 * tl + 2 * q));
            else h[tl] = (f32x4){0.f, 0.f, 0.f, 0.f}; }
        LDS_WAIT(); asm volatile("" ::: "memory");
        bf16x8 uq0, uq1, uq2, uq3; v2u pq0 = {0u, 0u}, pq1 = pq0, pq2 = pq0, pq3 = pq0, vq0 = pq0, vq1 = pq0, vq2 = pq0, vq3 = pq0;
#define S5_LOADTOK(kidx, UQ, PQ, VQ) do { const int tt_ = dir == 0 ? (kidx) : 63 - (kidx); UQ = *(const bf16x8*)(zrow + (size_t)tt_ * 2048 + 8 * (q & 1)); \
            if constexpr (OUT) { if (dir == 1) { PQ = *(const v2u*)(PART + (size_t)tt_ * 1024); VQ = *(const v2u*)(zrow + (size_t)tt_ * 2048 + 4 * q); } } } while (0)
        S5_LOADTOK(0, uq0, pq0, vq0); S5_LOADTOK(1, uq1, pq1, vq1); S5_LOADTOK(2, uq2, pq2, vq2); S5_LOADTOK(3, uq3, pq3, vq3);
#pragma unroll 1
        for (int k = 0; k < 64; ++k) {
            asm volatile("" ::: "memory");
            const int tt = dir == 0 ? k : 63 - k;
            const bf16x8 uvc = uq0; const v2u pf = pq0, u4 = vq0;
            uq0 = uq1; uq1 = uq2; uq2 = uq3; pq0 = pq1; pq1 = pq2; pq2 = pq3; vq0 = vq1; vq1 = vq2; vq2 = vq3;
            if (k + 4 < 64) S5_LOADTOK(k + 4, uq3, pq3, vq3);
            bf16x8 ub;
#pragma unroll
            for (int j = 0; j < 8; ++j) ub[j] = q < 2 ? uvc[j] : (short)0;
#pragma unroll
            for (int tl = 0; tl < 8; ++tl) {
                const f32x4 d = mfma16(bfl[tl * 64], ub, (f32x4){0.f, 0.f, 0.f, 0.f});
                const f32x4 hh = h[tl], lm = lam[tl];
                h[tl] = (f32x4){lm.x * hh.x - lm.y * hh.y + d.x, lm.x * hh.y + lm.y * hh.x + d.y, lm.z * hh.z - lm.w * hh.w + d.z, lm.z * hh.w + lm.w * hh.z + d.w};
            }
            if constexpr (OUT) {
                f32x4 y = {0.f, 0.f, 0.f, 0.f};
#pragma unroll
                for (int kt = 0; kt < 4; ++kt) { const f32x4 a0 = h[2 * kt], a1 = h[2 * kt + 1];
                    v4u w; w.x = pk2(a0.x, a0.y); w.y = pk2(a0.z, a0.w); w.z = pk2(a1.x, a1.y); w.w = pk2(a1.z, a1.w);
                    y = mfma16(((const LAS bf16x8*)wl + 512 + F.lane)[kt * 64], __builtin_bit_cast(bf16x8, w), y); }
                if (dir == 0) { v2u o; o.x = pk2(y.x, y.y); o.y = pk2(y.z, y.w); if (!skip_out) *(v2u*)(PART + (size_t)tt * 1024) = o; }
                else if (!skip_out) {
                    const float y0 = y.x + bflo(pf.x) + dsk.x * bflo(u4.x), y1 = y.y + bfhi(pf.x) + dsk.y * bfhi(u4.x), y2 = y.z + bflo(pf.y) + dsk.z * bflo(u4.y), y3 = y.w + bfhi(pf.y) + dsk.w * bfhi(u4.y);
                    v2u o; o.x = pk2(gelu_tanh(y0), gelu_tanh(y1)); o.y = pk2(gelu_tanh(y2), gelu_tanh(y3));
                    *(v2u*)(GO + (size_t)tt * 512) = o; }
            }
        }
#undef S5_LOADTOK
        if constexpr (!OUT) {
#pragma unroll
            for (int tl = 0; tl < 8; ++tl) *(f32x4*)((float*)(S5 + (((size_t)b * 2 + dir) * NSLOT5 + n64) * 2048 + g * 64 + 8 * tl + 2 * q)) = h[tl];
        }
    }
}
__device__ __forceinline__ void rescale_ssd_rows(Frame& F, int l, int r_lo) {
    const int gw = F.vcu * NWAVES + F.wave, NGW = F.G * NWAVES;
    const float* SSQ = (const float*)(F.ws + WS_SSQ); bf16* MIX = (bf16*)(F.ws + WS_MIX);
    const float* ng = INP(I_SNORMG) + l * 512 + 8 * F.lane;
    const f32x4 g0 = *(const f32x4*)ng, g1 = *(const f32x4*)(ng + 4);
    for (int r = r_lo + gw; r < RT; r += NGW) {
        const float sc = rsqrtf((SSQ[(size_t)r * 2] + SSQ[(size_t)r * 2 + 1]) * (1.f / 512.f) + EPS);
        v4u v = *(const v4u*)(MIX + (size_t)r * 1024 + 8 * F.lane);
        v.x = pk2(bflo(v.x) * sc * g0.x, bfhi(v.x) * sc * g0.y); v.y = pk2(bflo(v.y) * sc * g0.z, bfhi(v.y) * sc * g0.w);
        v.z = pk2(bflo(v.z) * sc * g1.x, bfhi(v.z) * sc * g1.y); v.w = pk2(bflo(v.w) * sc * g1.z, bfhi(v.w) * sc * g1.w);
        *(v4u*)(MIX + (size_t)r * 1024 + 8 * F.lane) = v;
    }
}
#ifndef PH_MASK
#define PH_MASK 0xFFFF
#endif
#ifndef DUP_MASK
#define DUP_MASK 0
#endif
#define PH(k) for (int rep_ = 0; rep_ < ((((PH_MASK) >> (k)) & 1) ? 1 + (((DUP_MASK) >> (k)) & 1) : 0); ++rep_)
#define LAUNDER() do { unsigned long long w_ = F.ptab[N_IN + 1], o_ = F.ptab[N_IN]; w_ = ((unsigned long long)(unsigned)__builtin_amdgcn_readfirstlane((int)(w_ >> 32)) << 32) | (unsigned)__builtin_amdgcn_readfirstlane((int)w_); o_ = ((unsigned long long)(unsigned)__builtin_amdgcn_readfirstlane((int)(o_ >> 32)) << 32) | (unsigned)__builtin_amdgcn_readfirstlane((int)o_); F.ws = (unsigned char*)(GAS unsigned char*)w_; F.out = (float*)(GAS float*)o_; F.ctl = (gu32*)(F.ws + WS_CTL); int t_ = threadIdx.x; asm volatile("" : "+v"(t_)); F.tid = t_; F.lane = t_ & 63; F.wave = __builtin_amdgcn_readfirstlane(t_ >> 6); F.G = gridDim.x; { const int bx = blockIdx.x; F.vcu = (F.G % 8 == 0) ? (bx % 8) * (F.G / 8) + bx / 8 : bx; } } while (0)
struct Args { const float* in[N_IN]; float* out; unsigned char* ws; };
__global__ void __launch_bounds__(NTHR, 2) mega_fwd(Args args) {
    extern __shared__ __attribute__((aligned(16))) unsigned char lds[];
    Frame F;
    F.lds = (LAS unsigned char*)lds;
    F.MISC = (volatile LAS unsigned*)(F.lds + MISC_OFF);
    F.tid = threadIdx.x; F.lane = F.tid & 63; F.wave = __builtin_amdgcn_readfirstlane(F.tid >> 6);
    F.G = gridDim.x; { const int bx = blockIdx.x; F.vcu = (F.G % 8 == 0) ? (bx % 8) * (F.G / 8) + bx / 8 : bx; }
    F.out = args.out; F.ws = args.ws;
    F.ctl = (gu32*)(F.ws + WS_CTL);
    for (int u = F.tid; u < (LDS_BYTES - LDSCTL_OFF) / 4; u += NTHR) ((LAS unsigned*)(F.lds + LDSCTL_OFF))[u] = 0u;
    __syncthreads();
    if (F.tid < N_IN) ((LAS unsigned long long*)(F.lds + PTAB_OFF))[F.tid] = (unsigned long long)args.in[F.tid];
    if (F.tid == N_IN) ((LAS unsigned long long*)(F.lds + PTAB_OFF))[N_IN] = (unsigned long long)args.out;
    if (F.tid == N_IN + 1) ((LAS unsigned long long*)(F.lds + PTAB_OFF))[N_IN + 1] = (unsigned long long)args.ws;
    F.ptab = (const LAS unsigned long long*)(F.lds + PTAB_OFF);
    __syncthreads();
    (void)xcd_barrier_post((unsigned*)(F.ctl + CW_BAR), F.MISC + 8);
#define GRID_BAR() do { XcdBarrier bar_; bar_.bar = (unsigned*)(F.ctl + CW_BAR); bar_.x = xb_xcc_id(); bar_.st = (volatile LAS unsigned*)(F.lds + MISC_OFF) + 8; xcd_barrier(bar_); LAUNDER(); } while (0)

    PH(0) { p0_ada_tables(F); LAUNDER(); convert_weights(F, 0, 32768); }
    GRID_BAR();
    PH(1) p1_norm1_first(F);
    GRID_BAR();

#pragma unroll 1
    for (int l = 0; l < DEPTH; ++l) {
        const bool last = (l == DEPTH - 1);
        const int r_lo = last ? RC : 0;
        const int t_lo = r_lo / 256, Mrows = RT - r_lo;
        PH(2) {
            pg8::Gemm g{(const bf16*)(F.ws + WS_A), (const bf16*)(F.ws + WS_WIN), RT, NZXU, 1024}; pg8::StaticOrder S; S.init(RT, NZXU, F.G, (int)blockIdx.x);
            pg8::EpiStoreBf16 E{(bf16*)(F.ws + WS_ZXU), NZXU};
            pg8::gemm_phase<pg8::EpiStoreBf16, pg8::StaticOrder, true, true>(F.lds, g, S, E, F.tid);
        }
        GRID_BAR();
        PH(3) for (int it = F.vcu; it < 272; it += F.G) ssd_states_item(F, l, it >> 1, it & 1);
        __syncthreads(); LAUNDER();
        PH(12) {
            const int gw = F.wave * F.G + F.vcu, NGW = F.G * NWAVES;
            for (int u = gw; u < S5_UNITS; u += NGW) s5_unit<false>(F, l, u, last, F.lds + F.wave * 12288);
        }
        GRID_BAR();
        PH(4) p4_scans(F, l);
        GRID_BAR();
        PH(5) for (int it = F.vcu; it < 272; it += F.G) { const int cidx = it >> 1; if (last && cidx < 8) continue; ssd_out_item(F, l, cidx, it & 1); }
        __syncthreads(); LAUNDER();
        PH(13) {
            const int gw = F.wave * F.G + F.vcu, NGW = F.G * NWAVES;
            for (int u = gw; u < S5_UNITS; u += NGW) s5_unit<true>(F, l, u, last, F.lds + F.wave * 12288);
        }
        GRID_BAR();
        PH(14) rescale_ssd_rows(F, l, r_lo);
        LAUNDER();
        PH(6) {
            const bf16* Gm = (const bf16*)(F.ws + WS_G) + (size_t)r_lo * 512;
            pg8::Gemm g{Gm, (const bf16*)(F.ws + WS_WGLU), Mrows, 512, 512}; pg8::StaticOrder S; S.init(Mrows, 512, F.G, (int)blockIdx.x);
            pg8::EpiGlu E{Gm, (bf16*)(F.ws + WS_MIX) + (size_t)r_lo * 1024 + 512, INP(I_GLUB) + l * 512};
            pg8::gemm_phase<pg8::EpiGlu, pg8::StaticOrder, true, true>(F.lds, g, S, E, F.tid);
        }
        GRID_BAR();
        PH(7) {
            pg8::Gemm g{(const bf16*)(F.ws + WS_MIX) + (size_t)r_lo * 1024, (const bf16*)(F.ws + WS_WOUT), Mrows, 1024, 1024}; pg8::StaticOrder S; S.init(Mrows, 1024, F.G, (int)blockIdx.x);
            pg8::EpiStoreF32 E{(float*)(F.ws + WS_ZXU) + (size_t)r_lo * 1024, 1024};
            pg8::gemm_phase<pg8::EpiStoreF32, pg8::StaticOrder, true, true>(F.lds, g, S, E, F.tid);
        }
        GRID_BAR();
        PH(8) p8_postmix(F, l, r_lo);
        GRID_BAR();
        PH(9) {
            const int tile0 = last ? 5 : 0, Mh = RH - tile0 * 256;
            pg8::Gemm g{(const bf16*)(F.ws + WS_A) + (size_t)tile0 * 256 * 1024, (const bf16*)(F.ws + WS_WUP), Mh, 5632, 1024}; pg8::StaticOrder S; S.init(Mh, 5632, F.G, (int)blockIdx.x);
            pg8::EpiFfnUp E{(bf16*)(F.ws + WS_HACT), INP(I_FCONVW) + (size_t)l * 3 * 5632, INP(I_FCONVB) + (size_t)l * 5632, tile0};
            pg8::gemm_phase<pg8::EpiFfnUp, pg8::StaticOrder, true, true>(F.lds, g, S, E, F.tid);
        }
        GRID_BAR();
        PH(10) {
            pg8::Gemm g{(const bf16*)(F.ws + WS_HACT) + (size_t)r_lo * 2816, (const bf16*)(F.ws + WS_WDOWN), Mrows, 1024, 2816}; pg8::StaticOrder S; S.init(Mrows, 1024, F.G, (int)blockIdx.x);
            pg8::EpiStoreF32 E{(float*)(F.ws + WS_FOUT) + (size_t)r_lo * 1024, 1024};
            pg8::gemm_phase<pg8::EpiStoreF32, pg8::StaticOrder, true, true>(F.lds, g, S, E, F.tid);
        }
        GRID_BAR();
        PH(11) p11_postffn(F, l, r_lo);
        if (!last) { __syncthreads(); LAUNDER(); PH(11) convert_weights(F, l + 1, 73728); GRID_BAR(); }
    }
}

extern "C" void kernel_launch(void* const* d_in, const int* in_sizes, int n_in, void* d_out, int out_size, void* d_ws, size_t ws_size, hipStream_t stream) {
    static int grid = 0;
    if (grid == 0) {
        if (n_in != N_IN || out_size != RL * DM || ws_size < WS_END) { fprintf(stderr, "kernel_launch: unexpected shapes (n_in %d, out %d, ws %zu); nothing launched\n", n_in, out_size, ws_size); grid = -1; return; }
        int dev = 0, cus = 0, per_cu = 0;
        if (hipGetDevice(&dev) != hipSuccess || hipDeviceGetAttribute(&cus, hipDeviceAttributeMultiprocessorCount, dev) != hipSuccess) { grid = -1; return; }
        if (hipFuncSetAttribute((const void*)mega_fwd, hipFuncAttributeMaxDynamicSharedMemorySize, LDS_BYTES) != hipSuccess) { fprintf(stderr, "kernel_launch: hipFuncSetAttribute failed\n"); grid = -1; return; }
        if (hipOccupancyMaxActiveBlocksPerMultiprocessor(&per_cu, (const void*)mega_fwd, NTHR, LDS_BYTES) != hipSuccess || per_cu < 1) { fprintf(stderr, "kernel_launch: occupancy query says %d\n", per_cu); }
        (void)hipGetLastError();
        grid = cus;
    }
    if (grid < 0) return;
    if (hipMemsetAsync((char*)d_ws + WS_CTL, 0, CTL_ZERO_BYTES, stream) != hipSuccess) return;
    Args a{};
    for (int i = 0; i < N_IN; ++i) a.in[i] = (const float*)d_in[i];
    a.out = (float*)d_out; a.ws = (unsigned char*)d_ws;
    hipLaunchKernelGGL(mega_fwd, dim3(grid), dim3(NTHR), LDS_BYTES, stream, a);
}
```

```cpp
#include <hip/hip_runtime.h>
#include <cstdio>
#include <cstdint>
namespace pg8 {
#define PG8_LAS __attribute__((address_space(3)))
typedef unsigned short bf16_t;
typedef short bf16x8 __attribute__((ext_vector_type(8)));
typedef float f32x4 __attribute__((ext_vector_type(4)));
typedef unsigned u32x4 __attribute__((ext_vector_type(4)));
constexpr int BM = 256, BK = 64, HALF = 128, HTB = HALF * BK * 2  , STAGE_BYTES = 8 * HTB, NXCD = 8, WGM = 8;

__host__ __device__ __forceinline__ int lds_byte(int r, int c) { const int st = (r >> 4) * 2 + (c >> 5), rr = r & 15, cc = c & 31, ob = rr * 64 + cc * 2; return st * 1024 + (ob ^ (((ob >> 9) & 1) << 5)); }
__host__ __device__ __forceinline__ void stage_rc(int b, int& R, int& C) { const int st = b / 1024, sb = b % 1024, swz = sb ^ (((sb >> 9) & 1) << 5); R = (st >> 1) * 16 + swz / 64; C = (st & 1) * 32 + (swz % 64) / 2; }
__host__ __device__ __forceinline__ int perm32(int rho) { const int n = rho >> 4, i = rho & 15; return 8 * (i >> 2) + 4 * n + (i & 3); }

struct Unit { int pm, pn; };
struct Gemm { const bf16_t* A; const bf16_t* Bt; int M, N, K; };

struct StaticOrder {
    int nM, nN, nwg, G, c;
    __host__ __device__ void init(int M, int N, int G_, int c_) { nM = M / BM; nN = N / BM; nwg = nM * nN; G = G_; c = c_; }
    __host__ __device__ bool next(int i, Unit& u) const {
        const long L = (long)i * G + c; if (L >= nwg) return false;
        int wgid = (int)L; { const int q = nwg / NXCD, r = nwg % NXCD, xcd = wgid % NXCD, off = wgid / NXCD; wgid = (xcd < r ? xcd * (q + 1) : r * (q + 1) + (xcd - r) * q) + off; }
        const int nig = WGM * nN, gid = wgid / nig, fm = gid * WGM, gsz = (nM - fm) < WGM ? (nM - fm) : WGM;
        u.pm = fm + ((wgid % nig) % gsz); u.pn = (wgid % nig) / gsz; return true;
    }
    __device__ __forceinline__ void a_ready(const Unit&) const {}
    __device__ __forceinline__ void done(const Unit&) const {}
};

__device__ __forceinline__ unsigned cvt_pk_bf16(float lo, float hi) { unsigned r; asm volatile("v_cvt_pk_bf16_f32 %0, %1, %2" : "=v"(r) : "v"(lo), "v"(hi)); return r; }
__device__ __forceinline__ float bf_lo(unsigned w) { return __uint_as_float(w << 16); }
__device__ __forceinline__ float bf_hi(unsigned w) { return __uint_as_float(w & 0xffff0000u); }
__device__ __forceinline__ float sigmoidf_(float x) { return 1.0f / (1.0f + __expf(-x)); }

struct EpiStoreBf16 {
    static constexpr bool PERM = true, AFTER_DRAIN = false;
    bf16_t* O; int ldc;
    __device__ __forceinline__ void operator()(const f32x4 (&acc)[2][2][4][2], const Unit& u, int wr, int wc, int fr, int fq) const {
        const int row0 = u.pm * BM + wr * 64 + fr, col0 = u.pn * BM + wc * 32 + 8 * fq;
#pragma unroll
        for (int ai = 0; ai < 2; ++ai)
#pragma unroll
            for (int m = 0; m < 4; ++m) { bf16_t* rowp = O + (size_t)(row0 + ai * HALF + m * 16) * ldc + col0;
#pragma unroll
                for (int bj = 0; bj < 2; ++bj) { const f32x4 v0 = acc[ai][bj][m][0], v1 = acc[ai][bj][m][1];
                    u32x4 w; w.x = cvt_pk_bf16(v0[0], v0[1]); w.y = cvt_pk_bf16(v0[2], v0[3]); w.z = cvt_pk_bf16(v1[0], v1[1]); w.w = cvt_pk_bf16(v1[2], v1[3]);
                    *(u32x4*)(rowp + bj * HALF) = w; } }
    }
};
struct EpiStoreF32 {
    static constexpr bool PERM = false, AFTER_DRAIN = false;
    float* C; int ldc;
    __device__ __forceinline__ void operator()(const f32x4 (&acc)[2][2][4][2], const Unit& u, int wr, int wc, int fr, int fq) const {
        const int row0 = u.pm * BM + wr * 64 + fr, col0 = u.pn * BM + wc * 32 + 4 * fq;
#pragma unroll
        for (int ai = 0; ai < 2; ++ai)
#pragma unroll
            for (int m = 0; m < 4; ++m) { float* rowp = C + (size_t)(row0 + ai * HALF + m * 16) * ldc + col0;
#pragma unroll
                for (int bj = 0; bj < 2; ++bj)
#pragma unroll
                    for (int n = 0; n < 2; ++n) *(f32x4*)(rowp + bj * HALF + n * 16) = acc[ai][bj][m][n]; }
    }
};
struct EpiGlu {
    static constexpr bool PERM = true, AFTER_DRAIN = false;
    const bf16_t* Gm; bf16_t* O; const float* bias;
    __device__ __forceinline__ void operator()(const f32x4 (&acc)[2][2][4][2], const Unit& u, int wr, int wc, int fr, int fq) const {
        const int row0 = u.pm * BM + wr * 64 + fr, col0 = u.pn * BM + wc * 32 + 8 * fq;
#pragma unroll
        for (int ai = 0; ai < 2; ++ai)
#pragma unroll
            for (int m = 0; m < 4; ++m) { const int r = row0 + ai * HALF + m * 16;
#pragma unroll
                for (int bj = 0; bj < 2; ++bj) { const int c = col0 + bj * HALF;
                    const u32x4 gv = *(const u32x4*)(Gm + (size_t)r * 512 + c);
                    const f32x4 b0 = *(const f32x4*)(bias + c), b1 = *(const f32x4*)(bias + c + 4);
                    const f32x4 v0 = acc[ai][bj][m][0] + b0, v1 = acc[ai][bj][m][1] + b1;
                    u32x4 w;
                    w.x = cvt_pk_bf16(bf_lo(gv.x) * sigmoidf_(v0[0]), bf_hi(gv.x) * sigmoidf_(v0[1]));
                    w.y = cvt_pk_bf16(bf_lo(gv.y) * sigmoidf_(v0[2]), bf_hi(gv.y) * sigmoidf_(v0[3]));
                    w.z = cvt_pk_bf16(bf_lo(gv.z) * sigmoidf_(v1[0]), bf_hi(gv.z) * sigmoidf_(v1[1]));
                    w.w = cvt_pk_bf16(bf_lo(gv.w) * sigmoidf_(v1[2]), bf_hi(gv.w) * sigmoidf_(v1[3]));
                    *(u32x4*)(O + (size_t)r * 1024 + c) = w; } }
    }
};
#ifndef FFN_USE_SHFL
__device__ __forceinline__ float dpp_prev(float cur, float below  , bool has_below) {
    const int old = has_below ? __builtin_amdgcn_update_dpp(0, __builtin_bit_cast(int, below), 0x121, 0xf, 0xf, false) : 0;
    return __builtin_bit_cast(float, __builtin_amdgcn_update_dpp(old, __builtin_bit_cast(int, cur), 0x111, 0xf, 0xf, false));
}
__device__ __forceinline__ float dpp_next(float cur, float above, bool has_above) {
    const int old = has_above ? __builtin_amdgcn_update_dpp(0, __builtin_bit_cast(int, above), 0x12F, 0xf, 0xf, false) : 0;
    return __builtin_bit_cast(float, __builtin_amdgcn_update_dpp(old, __builtin_bit_cast(int, cur), 0x101, 0xf, 0xf, false));
}
#endif
struct EpiFfnUp {
    static constexpr bool PERM = true, AFTER_DRAIN = false;
    bf16_t* H; const float* cw; const float* cb; int tile0;
    __device__ __forceinline__ void operator()(const f32x4 (&acc)[2][2][4][2], const Unit& u, int wr, int wc, int fr, int fq) const {
        typedef unsigned u32x2 __attribute__((ext_vector_type(2)));
        const int ch0 = u.pn * 128 + wc * 32 + 8 * fq;
#ifdef FFN_USE_SHFL
        const int lane = fr + 16 * fq;
        const int lm1 = (lane + 63) & 63, lp15 = (lane + 15) & 63, lp1 = (lane + 1) & 63, lm15 = (lane + 49) & 63;
#endif
        const int T = tile0 + u.pm;
        const bool isctx = T < 5;
#pragma unroll
        for (int n = 0; n < 2; ++n) {
            f32x4 w0[2], w1[2], w2[2], bb[2];
#pragma unroll
            for (int h = 0; h < 2; ++h) { const int col = h * 2816 + ch0 + 4 * n;
                w0[h] = *(const f32x4*)(cw + col); w1[h] = *(const f32x4*)(cw + 5632 + col); w2[h] = *(const f32x4*)(cw + 2 * 5632 + col); bb[h] = *(const f32x4*)(cb + col); }
#pragma unroll
            for (int ai = 0; ai < 2; ++ai) {
                const int B = T * 4 + ai * 2 + wr;
                int orow0, tok0 = 0;
                if (isctx) { const int b = B / 5, blk = B - 5 * b; tok0 = 62 * blk - 1; orow0 = b * 256 + tok0; }
                else orow0 = 1024 + (T - 5) * 256 + ai * 128 + wr * 64;
#pragma unroll
                for (int m = 0; m < 4; ++m) {
                    f32x4 cv[2];
#pragma unroll
                    for (int h = 0; h < 2; ++h) {
                        f32x4 o;
#pragma unroll
                        for (int j = 0; j < 4; ++j) {
                            const float cur = acc[ai][h][m][n][j];
#ifdef FFN_USE_SHFL
                            const float pa = __shfl(cur, lm1);
                            const float pb = (m > 0) ? __shfl(acc[ai][h][m > 0 ? m - 1 : 0][n][j], lp15) : 0.f;
                            const float na = __shfl(cur, lp1);
                            const float nb = (m < 3) ? __shfl(acc[ai][h][m < 3 ? m + 1 : 3][n][j], lm15) : 0.f;
                            const float prev = fr > 0 ? pa : pb, next = fr < 15 ? na : nb;
#else
                            const float prev = dpp_prev(cur, acc[ai][h][m > 0 ? m - 1 : 0][n][j], m > 0);
                            const float next = dpp_next(cur, acc[ai][h][m < 3 ? m + 1 : 3][n][j], m < 3);
#endif
                            o[j] = bb[h][j] + w0[h][j] * prev + w1[h][j] * cur + w2[h][j] * next;
                        }
                        cv[h] = o;
                    }
                    const int i = 16 * m + fr;
                    bool valid = true;
                    if (isctx) valid = (i >= 1) && (i <= 62) && (tok0 + i < 256);
                    float o[4];
#pragma unroll
                    for (int j = 0; j < 4; ++j) { const float g = cv[0][j], v = cv[1][j]; o[j] = g * sigmoidf_(g) * v; }
                    u32x2 w; w.x = cvt_pk_bf16(o[0], o[1]); w.y = cvt_pk_bf16(o[2], o[3]);
                    if (valid) *(u32x2*)(H + (size_t)(orow0 + i) * 2816 + ch0 + 4 * n) = w;
                }
            }
        }
    }
};

template <class Epi, class Sched, bool ALIGN_EPI = false, bool SP2 = false>
__device__ __forceinline__ void gemm_phase(PG8_LAS unsigned char* lds, const Gemm g, const Sched& S, const Epi& E, const int tid_in) {
    const int tid = tid_in, wid = __builtin_amdgcn_readfirstlane(tid >> 6), lane = tid & 63, wr = wid >> 2, wc = wid & 3, fr = lane & 15, fq = lane >> 4;
    const int K = g.K, nt = K / BK;
    unsigned voffA[2], voffB[2];
#pragma unroll
    for (int i = 0; i < 2; ++i) { int R, C; stage_rc(tid * 16 + i * 8192, R, C); const int Rb = Epi::PERM ? ((R & ~31) + perm32(R & 31)) : R;
        voffA[i] = (unsigned)(R * K + C) * 2u; voffB[i] = (unsigned)(Rb * K + C) * 2u; }
    const size_t kstep = (size_t)(BK * 2);
    const size_t hstep = (size_t)HALF * K * 2;
    const size_t tstep = 2 * hstep;
    const unsigned ldsw = (unsigned)wid * 1024u;
    const int aoff = lds_byte(wr * 64 + fr, fq * 8), boff = lds_byte(wc * 32 + fr, fq * 8);
#define PG8_SA(b, h) (((b) * 2 + (h)) * HTB)
#define PG8_SB(b, h) ((4 + (b) * 2 + (h)) * HTB)
#define PG8_STAGE(bufoff, gbase, voff) do { _Pragma("unroll") for (int _i = 0; _i < 2; ++_i) \
        __builtin_amdgcn_global_load_lds((const unsigned*)((const char*)(gbase) + (voff)[_i]), (PG8_LAS unsigned*)(lds + (bufoff) + ldsw + _i * 8192), 16, 0, 0); } while (0)
#define PG8_LDA(dst, b, h) do { _Pragma("unroll") for (int m = 0; m < 4; ++m) _Pragma("unroll") for (int k = 0; k < 2; ++k) dst[m][k] = *(const PG8_LAS bf16x8*)(lds + PG8_SA(b, h) + aoff + m * 2048 + k * 1024); } while (0)
#define PG8_LDB(dst, b, h) do { _Pragma("unroll") for (int n = 0; n < 2; ++n) _Pragma("unroll") for (int k = 0; k < 2; ++k) dst[n][k] = *(const PG8_LAS bf16x8*)(lds + PG8_SB(b, h) + boff + n * 2048 + k * 1024); } while (0)
#define PG8_MMA(ai, bj, At, Bt) do { __builtin_amdgcn_s_setprio(1); _Pragma("unroll") for (int m = 0; m < 4; ++m) _Pragma("unroll") for (int n = 0; n < 2; ++n) _Pragma("unroll") for (int k = 0; k < 2; ++k) \
        acc[ai][bj][m][n] = __builtin_amdgcn_mfma_f32_16x16x32_bf16(Bt[n][k], At[m][k], acc[ai][bj][m][n], 0, 0, 0); __builtin_amdgcn_s_setprio(0); } while (0)
#define PG8_WAIT_V(n) asm volatile("s_waitcnt vmcnt(" #n ")" ::: "memory")
#define PG8_WAIT_L(n) asm volatile("s_waitcnt lgkmcnt(" #n ")" ::: "memory")
#define PG8_BAR __builtin_amdgcn_s_barrier()
#define PG8_SCHED __builtin_amdgcn_sched_barrier(0)
    Unit cur, nxt; int ui = 0;
    if (!S.next(0, cur)) return;
    f32x4 acc[2][2][4][2];
#pragma unroll
    for (int a = 0; a < 2; ++a)
#pragma unroll
        for (int b = 0; b < 2; ++b)
#pragma unroll
            for (int m = 0; m < 4; ++m)
#pragma unroll
                for (int n = 0; n < 2; ++n) acc[a][b][m][n] = (f32x4){0.f, 0.f, 0.f, 0.f};
    bf16x8 At[4][2], B0[2][2], B1[2][2];
    const char* cA = (const char*)g.A + (size_t)cur.pm * tstep; const char* cB = (const char*)g.Bt + (size_t)cur.pn * tstep;
    S.a_ready(cur);
    if constexpr (SP2) {
        PG8_STAGE(PG8_SB(0, 0), cB, voffB); PG8_STAGE(PG8_SB(0, 1), cB + hstep, voffB); PG8_STAGE(PG8_SA(0, 0), cA, voffA); PG8_STAGE(PG8_SA(0, 1), cA + hstep, voffA);
        if (wr == 1) PG8_BAR;
        PG8_WAIT_V(2); PG8_BAR;
        PG8_STAGE(PG8_SB(1, 0), cB + kstep, voffB); PG8_STAGE(PG8_SA(1, 0), cA + kstep, voffA); PG8_STAGE(PG8_SB(1, 1), cB + hstep + kstep, voffB);
        PG8_WAIT_V(6); PG8_BAR;
    } else {
        PG8_STAGE(PG8_SB(0, 0), cB, voffB); PG8_STAGE(PG8_SA(0, 0), cA, voffA); PG8_STAGE(PG8_SB(0, 1), cB + hstep, voffB); PG8_STAGE(PG8_SA(0, 1), cA + hstep, voffA);
        if (wr == 1) PG8_BAR;
        PG8_WAIT_V(4); PG8_BAR;
        PG8_STAGE(PG8_SB(1, 0), cB + kstep, voffB); PG8_STAGE(PG8_SA(1, 0), cA + kstep, voffA); PG8_STAGE(PG8_SB(1, 1), cB + hstep + kstep, voffB);
        PG8_WAIT_V(6); PG8_BAR;
    }
    for (;;) {
        const bool has_next = S.next(ui + 1, nxt);
        const char* nA = has_next ? (const char*)g.A + (size_t)nxt.pm * tstep : cA; const char* nB = has_next ? (const char*)g.Bt + (size_t)nxt.pn * tstep : cB;
        for (int t = 0; t < nt; t += 2) {
            const bool last = (t == nt - 2);
            const char* a1 = cA + (size_t)(t + 1) * kstep;
            const char* a2 = last ? nA : cA + (size_t)(t + 2) * kstep; const char* b2 = last ? nB : cB + (size_t)(t + 2) * kstep;
            const char* a3 = a2 + kstep; const char* b3 = b2 + kstep;
            if (last && has_next) S.a_ready(nxt);
            if constexpr (SP2) {
            PG8_LDB(B0, 0, 0); PG8_LDB(B1, 0, 1); PG8_SCHED; PG8_LDA(At, 0, 0); PG8_STAGE(PG8_SA(1, 1), a1 + hstep, voffA);
            PG8_WAIT_V(8); PG8_WAIT_L(0); PG8_BAR; PG8_MMA(0, 0, At, B0); PG8_MMA(0, 1, At, B1); PG8_BAR; PG8_SCHED;
            PG8_LDA(At, 0, 1); PG8_STAGE(PG8_SB(0, 0), b2, voffB); PG8_STAGE(PG8_SB(0, 1), b2 + hstep, voffB); PG8_STAGE(PG8_SA(0, 0), a2, voffA);
            PG8_WAIT_V(8); PG8_WAIT_L(0); PG8_BAR; PG8_MMA(1, 0, At, B0); PG8_MMA(1, 1, At, B1); PG8_BAR; PG8_SCHED;
            PG8_LDB(B0, 1, 0); PG8_LDB(B1, 1, 1); PG8_SCHED; PG8_LDA(At, 1, 0); PG8_STAGE(PG8_SA(0, 1), a2 + hstep, voffA);
            PG8_WAIT_V(8); PG8_WAIT_L(0); PG8_BAR; PG8_MMA(0, 0, At, B0); PG8_MMA(0, 1, At, B1); PG8_BAR; PG8_SCHED;
            PG8_LDA(At, 1, 1); PG8_STAGE(PG8_SB(1, 0), b3, voffB); PG8_STAGE(PG8_SB(1, 1), b3 + hstep, voffB); PG8_STAGE(PG8_SA(1, 0), a3, voffA);
            PG8_WAIT_V(8); PG8_WAIT_L(0); PG8_BAR; PG8_MMA(1, 0, At, B0); PG8_MMA(1, 1, At, B1); PG8_BAR; PG8_SCHED;
            } else {
            PG8_LDB(B0, 0, 0); PG8_SCHED; PG8_LDA(At, 0, 0); PG8_STAGE(PG8_SA(1, 1), a1 + hstep, voffA);
            PG8_WAIT_L(8); PG8_BAR; PG8_WAIT_L(0); PG8_MMA(0, 0, At, B0); PG8_BAR; PG8_SCHED;
            PG8_LDB(B1, 0, 1); PG8_STAGE(PG8_SB(0, 0), b2, voffB);
            PG8_BAR; PG8_WAIT_L(0); PG8_MMA(0, 1, At, B1); PG8_BAR;
            PG8_LDA(At, 0, 1); PG8_STAGE(PG8_SA(0, 0), a2, voffA);
            PG8_BAR; PG8_WAIT_L(0); PG8_MMA(1, 0, At, B0); PG8_BAR; PG8_SCHED;
            PG8_STAGE(PG8_SB(0, 1), b2 + hstep, voffB);
            PG8_WAIT_V(6); PG8_BAR; PG8_MMA(1, 1, At, B1); PG8_BAR;
            PG8_LDB(B0, 1, 0); PG8_SCHED; PG8_LDA(At, 1, 0); PG8_STAGE(PG8_SA(0, 1), a2 + hstep, voffA);
            PG8_WAIT_L(8); PG8_BAR; PG8_WAIT_L(0); PG8_MMA(0, 0, At, B0); PG8_BAR; PG8_SCHED;
            PG8_LDB(B1, 1, 1); PG8_STAGE(PG8_SB(1, 0), b3, voffB);
            PG8_BAR; PG8_WAIT_L(0); PG8_MMA(0, 1, At, B1); PG8_BAR;
            PG8_LDA(At, 1, 1); PG8_STAGE(PG8_SA(1, 0), a3, voffA);
            PG8_BAR; PG8_WAIT_L(0); PG8_MMA(1, 0, At, B0); PG8_BAR; PG8_SCHED;
            PG8_STAGE(PG8_SB(1, 1), b3 + hstep, voffB);
            PG8_WAIT_V(6); PG8_BAR; PG8_MMA(1, 1, At, B1); PG8_BAR;
            }
        }
        if constexpr (ALIGN_EPI) { if (wr == 0) PG8_BAR; }
        if constexpr (!Epi::AFTER_DRAIN) { E(acc, cur, wr, wc, fr, fq); S.done(cur); }
        if (!has_next) break;
#pragma unroll
        for (int a = 0; a < 2; ++a)
#pragma unroll
            for (int b = 0; b < 2; ++b)
#pragma unroll
                for (int m = 0; m < 4; ++m)
#pragma unroll
                    for (int n = 0; n < 2; ++n) acc[a][b][m][n] = (f32x4){0.f, 0.f, 0.f, 0.f};
        cur = nxt; cA = nA; cB = nB; ++ui;
        if constexpr (ALIGN_EPI) { if (wr == 1) PG8_BAR; }
    }
    PG8_WAIT_V(0);
    if constexpr (!ALIGN_EPI) { if (wr == 0) PG8_BAR; }
    PG8_BAR;
    if constexpr (Epi::AFTER_DRAIN) { E.fused(acc, cur, wr, wc, fr, fq, lds, wid, lane); S.done(cur); }
#undef PG8_SA
#undef PG8_SB
#undef PG8_STAGE
#undef PG8_LDA
#undef PG8_LDB
#undef PG8_MMA
#undef PG8_WAIT_V
#undef PG8_WAIT_L
#undef PG8_BAR
#undef PG8_SCHED
}
}
#ifndef S5_VALU_MASK
#define S5_VALU_MASK 0
#endif
constexpr int NWAVES = 8, NTHR = 512;
constexpr int DM = 1024, NB = 4, SEQ = 4096, CTXL = 256, DEPTH = 2;
constexpr int RC = NB * CTXL, RL = NB * SEQ, RT = RC + RL;
constexpr int RH = 1280 + RL;
constexpr int DSSD = 512, NHEAD = 8, HD = 64, NGRP = 2, HPG = 4, NST = 128, QCH = 128;
constexpr int DS5 = 512, S5C = 16, S5G = 32, S5P = 64;
constexpr int DFF = 2816, XBC = 1024, DPROJ = 2064, NZXU = 2048;
constexpr int S5L = 32, S5NC = CTXL / S5L, NSLOT5 = (CTXL + SEQ) / S5L;
constexpr int NSLOT = 34;
constexpr float EPS = 1e-6f;
enum { I_X = 0, I_C, I_CTX, I_CCTX, I_WADA, I_BADA, I_GPREMIX, I_GPOSTMIX, I_GPREFFN, I_GPOSTFFN, I_WIN, I_SCONVW, I_SCONVB, I_DTBIAS, I_ALOG, I_SSDD, I_SNORMG,
       I_ARE, I_AIM, I_LOGDT, I_BRE, I_BIM, I_CRE, I_CIM, I_S5D, I_GLUW, I_GLUB, I_WOUT, I_WUP, I_FCONVW, I_FCONVB, I_WDOWN, N_IN };
constexpr size_t KiB = 1024, MiB = 1u << 20;
constexpr size_t WS_CTL = 0, CTL_ZERO_BYTES = 64 * KiB;
constexpr size_t WS_ADA = 1 * MiB;
constexpr size_t WS_LAMB = 1 * MiB + 512 * KiB;
constexpr size_t WS_LAMQ = WS_LAMB + 64 * KiB;
constexpr size_t WS_CMAT = WS_LAMQ + 64 * KiB;
constexpr size_t WS_BBAR = 2 * MiB;
constexpr size_t WS_DT = 4 * MiB;
constexpr size_t WS_SSQ = 5 * MiB + 512 * KiB;
constexpr size_t WS_DEC = 5 * MiB + 768 * KiB;
constexpr size_t WS_S5ST = 229 * MiB;
constexpr size_t WS_CTXX = 15 * MiB;
constexpr size_t WS_WIN = 19 * MiB, WS_WGLU = 23 * MiB, WS_WOUT = 23 * MiB + 512 * KiB, WS_WUP = 25 * MiB + 512 * KiB, WS_WDOWN = 36 * MiB + 512 * KiB;
constexpr size_t WS_A = 42 * MiB;
constexpr size_t WS_MIX = 110 * MiB;
constexpr size_t WS_G = 144 * MiB;
constexpr size_t WS_ZXU = 161 * MiB;
constexpr size_t WS_HACT = 80 * MiB;
constexpr size_t WS_FOUT = 174 * MiB;
constexpr size_t WS_END = 246 * MiB;
constexpr int CW_BAR = 4096;
constexpr int RING_BYTES = 131072;
constexpr int LDS_BYTES = 163840;
constexpr int LDSCTL_OFF = LDS_BYTES - 1024, MISC_OFF = LDSCTL_OFF + 320, PTAB_OFF = LDSCTL_OFF + 512;

#define GAS __attribute__((address_space(1)))
#define LAS __attribute__((address_space(3)))
typedef unsigned short bf16;
typedef unsigned v4u __attribute__((ext_vector_type(4)));
typedef unsigned v2u __attribute__((ext_vector_type(2)));
typedef float f32x4 __attribute__((ext_vector_type(4)));
typedef float f32x2 __attribute__((ext_vector_type(2)));
typedef short bf16x8 __attribute__((ext_vector_type(8)));
typedef GAS unsigned gu32;
#define RLX_AGENT __ATOMIC_RELAXED, __HIP_MEMORY_SCOPE_AGENT
#define LDS_WAIT() asm volatile("s_waitcnt lgkmcnt(0)" ::: "memory")
__device__ __forceinline__ unsigned f2bf(float f) { unsigned u = __builtin_bit_cast(unsigned, f); return (u + 0x7fffu + ((u >> 16) & 1u)) >> 16; }
__device__ __forceinline__ unsigned pk2(float lo, float hi) { return f2bf(lo) | (f2bf(hi) << 16); }
__device__ __forceinline__ float bf2f(unsigned h) { return __uint_as_float(h << 16); }
__device__ __forceinline__ float bflo(unsigned w) { return __uint_as_float(w << 16); }
__device__ __forceinline__ float bfhi(unsigned w) { return __uint_as_float(w & 0xffff0000u); }
__device__ __forceinline__ float siluf_(float x) { return x / (1.0f + __expf(-x)); }
#define XB_TMO      128
#define XB_XCNT(j)  (256  + 64 * (j))
#define XB_XSUB(j)  (1280 + 64 * (j))
#define XB_XGEN(j)  (2304 + 64 * (j))
#define XB_TOP      3328
#define XB_TOPGEN   3392
#define XCD_BAR_WORDS 3456
#define XB_SPIN_CAP (1u << 18)

__device__ __forceinline__ unsigned xb_ld(unsigned* p)              { return __hip_atomic_load(p, __ATOMIC_RELAXED, __HIP_MEMORY_SCOPE_AGENT); }
__device__ __forceinline__ unsigned xb_add(unsigned* p, unsigned v) { return __hip_atomic_fetch_add(p, v, __ATOMIC_RELAXED, __HIP_MEMORY_SCOPE_AGENT); }
__device__ __forceinline__ unsigned xb_xcc_id() { return (unsigned)__builtin_amdgcn_s_getreg((3 << 11) | 20) & 0xFu; }
#define XB_SPIN(cond, bar) do { unsigned _sp = 0; while (cond) { __builtin_amdgcn_s_sleep(1); \
    if ((++_sp & 255u) == 0u) { if (xb_ld(&(bar)[XB_TMO])) break; if (_sp > XB_SPIN_CAP) { atomicAdd(&(bar)[XB_TMO], 1u); break; } } } } while (0)

struct XcdBarrier {
    unsigned* bar; unsigned x;
    volatile LAS unsigned* st;
};

__device__ __forceinline__ XcdBarrier xcd_barrier_post(unsigned* bar, volatile LAS unsigned* st) {
    XcdBarrier b; b.bar = bar; b.x = xb_xcc_id(); b.st = st;
    if (threadIdx.x == 0) (void)xb_add(&bar[XB_XCNT(b.x)], 1u);
    return b;
}
__device__ __forceinline__ void xcd_barrier_complete(unsigned* bar, unsigned x, unsigned& nloc, unsigned& nx) {
    const unsigned G = gridDim.x * gridDim.y * gridDim.z;
    unsigned sum, cnt, mine, sp = 0u;
    for (;;) {
        sum = 0u; cnt = 0u; mine = 0u;
#pragma unroll
        for (unsigned j = 0; j < 16; ++j) { const unsigned c = xb_ld(&bar[XB_XCNT(j)]); sum += c; cnt += (c > 0u) ? 1u : 0u; mine = (j == x) ? c : mine; }
        if (sum == G) break;
        __builtin_amdgcn_s_sleep(1);
        if ((++sp & 255u) == 0u) { if (xb_ld(&bar[XB_TMO])) break; if (sp > XB_SPIN_CAP) { atomicAdd(&bar[XB_TMO], 1u); break; } }
    }
    nloc = mine > 0u ? mine : 1u; nx = cnt > 0u ? cnt : 1u;
}

__device__ __forceinline__ void xcd_barrier(const XcdBarrier& b) {
    asm volatile("s_waitcnt vmcnt(0)" ::: "memory");
    __syncthreads();
    if (threadIdx.x == 0) {
        unsigned* bar = b.bar;
        __builtin_amdgcn_s_waitcnt(0);
        unsigned nloc = b.st[0], nx = b.st[1];
        if (nloc == 0u) { xcd_barrier_complete(bar, b.x, nloc, nx); b.st[0] = nloc; b.st[1] = nx; }
        const unsigned old = xb_add(&bar[XB_XSUB(b.x)], 1u);
        const unsigned gen = old / nloc;
        if (old + 1u == (gen + 1u) * nloc) {
            __builtin_amdgcn_fence(__ATOMIC_RELEASE, "agent");
            asm volatile("s_waitcnt vmcnt(0)" ::: "memory");
            const unsigned og = xb_add(&bar[XB_TOP], 1u);
            const unsigned tg = og / nx;
            if (og + 1u == (tg + 1u) * nx) xb_add(&bar[XB_TOPGEN], 1u);
            else XB_SPIN(xb_ld(&bar[XB_TOPGEN]) == tg, bar);
            __builtin_amdgcn_fence(__ATOMIC_ACQUIRE, "agent");
            xb_add(&bar[XB_XGEN(b.x)], 1u);
            asm volatile("s_waitcnt vmcnt(0)" ::: "memory");
        } else {
            XB_SPIN(xb_ld(&bar[XB_XGEN(b.x)]) == gen, bar);
            __builtin_amdgcn_fence(__ATOMIC_ACQUIRE, "agent");
            asm volatile("s_waitcnt vmcnt(0)" ::: "memory");
        }
    }
    __syncthreads();
}
struct Frame {
    LAS unsigned char* lds;
    volatile LAS unsigned* MISC;
    gu32* ctl;
    int tid, lane, wave;
    int vcu, G;
    const LAS unsigned long long* ptab;
    float* out;
    unsigned char* ws;
};
#define INP(i) ((const float*)(GAS const float*)F.ptab[(i)])
__device__ __forceinline__ float wave_sum(float v) {
#pragma unroll
    for (int o = 1; o < 64; o <<= 1) v += __shfl_xor(v, o);
    return v;
}
__device__ __forceinline__ int row_batch(int r) { return r < RC ? (r >> 8) : ((r - RC) >> 12); }
__device__ __forceinline__ int row_modv(int r) { return r < RC ? 4 : ((r - RC) >> 12); }

__device__ __forceinline__ void p0_ada_tables(Frame& F) {
    LAS float* sc = (LAS float*)(F.lds);
    LAS float* red = sc + 5 * 1024;
    const float* cv = INP(I_C); const float* cc = INP(I_CCTX);
    for (int i = F.tid; i < 5120; i += NTHR) { const int v = i >> 10, k = i & 1023; const float c = v < 4 ? cv[v * 1024 + k] : cc[k]; sc[i] = c / (1.0f + expf(-c)); }
    __syncthreads();
    float* ada = (float*)(F.ws + WS_ADA);
    const float* wada = INP(I_WADA); const float* bada = INP(I_BADA);
    for (int unit = F.vcu; unit < 384; unit += F.G) {
        const int l = unit / 192, j0 = (unit % 192) * 32, col = F.tid & 31, kq = F.tid >> 5;
        float acc[5] = {0.f, 0.f, 0.f, 0.f, 0.f};
        const float* w = wada + (size_t)l * 1024 * 6144 + j0 + col;
#pragma unroll 8
        for (int k = kq; k < 1024; k += 16) { const float wv = w[(size_t)k * 6144];
#pragma unroll
            for (int v = 0; v < 5; ++v) acc[v] += sc[v * 1024 + k] * wv; }
#pragma unroll
        for (int v = 0; v < 5; ++v) red[(kq * 5 + v) * 32 + col] = acc[v];
        __syncthreads();
        if (F.tid < 160) { const int v = F.tid >> 5, c2 = F.tid & 31; float s = 0.f;
#pragma unroll
            for (int q = 0; q < 16; ++q) s += red[(q * 5 + v) * 32 + c2];
            ada[(l * 5 + v) * 6144 + j0 + c2] = s + bada[l * 6144 + j0 + c2]; }
        __syncthreads();
    }
    const int gt = F.vcu * NTHR + F.tid, GT = F.G * NTHR;
    f32x2* LAMB = (f32x2*)(F.ws + WS_LAMB); f32x2* LAMQ = (f32x2*)(F.ws + WS_LAMQ); bf16* BBT = (bf16*)(F.ws + WS_BBAR); bf16* CMAT = (bf16*)(F.ws + WS_CMAT);
    for (int idx = gt; idx < 2 * 2 * 32 * 64; idx += GT) {
        const int l = idx >> 12, dir = (idx >> 11) & 1, g = (idx >> 6) & 31, p = idx & 63;
        const double dtv = exp((double)INP(I_LOGDT)[(l * 2 + dir) * 32 + g]);
        const double are = (double)INP(I_ARE)[idx], aim = (double)INP(I_AIM)[idx];
        const double er = exp(are * dtv), lr = er * cos(aim * dtv), li = er * sin(aim * dtv);
        const double eq = exp((double)S5L * are * dtv), qr = eq * cos((double)S5L * aim * dtv), qi = eq * sin((double)S5L * aim * dtv);
        const double nr = lr - 1.0, ni = li, den = are * are + aim * aim;
        const double cr = (nr * are + ni * aim) / den, ci = (ni * are - nr * aim) / den;
        LAMB[idx] = (f32x2){(float)lr, (float)li}; LAMQ[idx] = (f32x2){(float)qr, (float)qi};
        const float* bre = INP(I_BRE) + ((size_t)(l * 32 + g) * 64 + p) * 16; const float* bim = INP(I_BIM) + ((size_t)(l * 32 + g) * 64 + p) * 16;
        unsigned wre[8], wim[8];
#pragma unroll
        for (int c = 0; c < 16; c += 2) { const double br0 = bre[c], bi0 = bim[c], br1 = bre[c + 1], bi1 = bim[c + 1];
            wre[c >> 1] = pk2((float)(cr * br0 - ci * bi0), (float)(cr * br1 - ci * bi1)); wim[c >> 1] = pk2((float)(cr * bi0 + ci * br0), (float)(cr * bi1 + ci * br1)); }
        v4u* dst = (v4u*)(BBT + (size_t)idx * 32);
        dst[0] = (v4u){wre[0], wre[1], wre[2], wre[3]}; dst[1] = (v4u){wre[4], wre[5], wre[6], wre[7]};
        dst[2] = (v4u){wim[0], wim[1], wim[2], wim[3]}; dst[3] = (v4u){wim[4], wim[5], wim[6], wim[7]};
    }
    for (int idx = gt; idx < 2 * 32 * 16 * 64; idx += GT) {
        const int p = idx & 63, lgc = idx >> 6;
        const float cre = INP(I_CRE)[idx], cim = INP(I_CIM)[idx];
        *(unsigned*)(CMAT + (size_t)lgc * 128 + 2 * p) = pk2(cre, -cim);
    }
}
__device__ __forceinline__ void transpose_item(const float* W, int ldw, int k0, int nsrc0, bf16* WT, int K, int ndst0, LAS float* scr, int lane) {
#pragma unroll 8
    for (int i = 0; i < 32; ++i) { const int kk = 2 * i + (lane >> 5); scr[kk * 33 + (lane & 31)] = W[(size_t)(k0 + kk) * ldw + nsrc0 + (lane & 31)]; }
    LDS_WAIT(); asm volatile("" ::: "memory");
    const int c = lane & 7;
#pragma unroll
    for (int j = 0; j < 4; ++j) { const int n = (lane >> 3) + 8 * j; const LAS float* s = scr + (8 * c) * 33 + n;
        v4u o; o.x = pk2(s[0 * 33], s[1 * 33]); o.y = pk2(s[2 * 33], s[3 * 33]); o.z = pk2(s[4 * 33], s[5 * 33]); o.w = pk2(s[6 * 33], s[7 * 33]);
        *(GAS v4u*)(WT + (size_t)(ndst0 + n) * K + k0 + 8 * c) = o; }
    LDS_WAIT(); asm volatile("" ::: "memory");
}
__device__ __forceinline__ void convert_weights(Frame& F, int l, int lds_off) {
    LAS float* scr = (LAS float*)(F.lds + lds_off + F.wave * 8448);
    const int gw = F.vcu * NWAVES + F.wave, NGW = F.G * NWAVES;
    constexpr int I_IN = 16 * 64, I_GL = 8 * 16, I_OUT = 16 * 32, I_UP = 16 * 176, I_DN = 44 * 32;
    constexpr int NIT = I_IN + I_GL + I_OUT + I_UP + I_DN;
    const float* win = INP(I_WIN) + (size_t)l * 1024 * DPROJ; const float* wglu = INP(I_GLUW) + (size_t)l * 512 * 512; const float* wout = INP(I_WOUT) + (size_t)l * 1024 * 1024;
    const float* wup = INP(I_WUP) + (size_t)l * 1024 * 5632; const float* wdn = INP(I_WDOWN) + (size_t)l * 2816 * 1024;
    for (int it = gw; it < NIT; it += NGW) {
        int r = it;
        if (r < I_IN) { const int kb = r >> 6, nb = r & 63, d0 = nb * 32, s0 = d0 < 1536 ? d0 : d0 + 16; transpose_item(win, DPROJ, kb * 64, s0, (bf16*)(F.ws + WS_WIN), 1024, d0, scr, F.lane); continue; } r -= I_IN;
        if (r < I_GL) { const int kb = r >> 4, nb = r & 15; transpose_item(wglu, 512, kb * 64, nb * 32, (bf16*)(F.ws + WS_WGLU), 512, nb * 32, scr, F.lane); continue; } r -= I_GL;
        if (r < I_OUT) { const int kb = r >> 5, nb = r & 31; transpose_item(wout, 1024, kb * 64, nb * 32, (bf16*)(F.ws + WS_WOUT), 1024, nb * 32, scr, F.lane); continue; } r -= I_OUT;
        if (r < I_UP) { const int kb = r / 176, nb = r % 176, d0 = nb * 32, pn = d0 >> 8, h = (d0 >> 7) & 1, j = d0 & 127, s0 = h * 2816 + 128 * pn + j;
            transpose_item(wup, 5632, kb * 64, s0, (bf16*)(F.ws + WS_WUP), 1024, d0, scr, F.lane); continue; } r -= I_UP;
        { const int kb = r >> 5, nb = r & 31; transpose_item(wdn, 1024, kb * 64, nb * 32, (bf16*)(F.ws + WS_WDOWN), 2816, nb * 32, scr, F.lane); }
    }
}
__device__ __forceinline__ float softplusf_(float x) { return x > 20.f ? x : log1pf(expf(x)); }
__device__ __forceinline__ void stage_wdt(Frame& F, int l) {
    LAS float* wdt = (LAS float*)F.lds;
    const float* win = INP(I_WIN) + (size_t)l * 1024 * DPROJ + 1536;
    for (int i = F.tid; i < 1024 * 4; i += NTHR) { const int k = i >> 2, q = i & 3; *(LAS f32x4*)(wdt + k * 16 + (k >> 2) * 4 + 4 * q) = *(const f32x4*)(win + (size_t)k * DPROJ + 4 * q); }
    __syncthreads();
}
__device__ __forceinline__ void norm1_row(Frame& F, int l, int r, const f32x4 (&xv)[4]) {
    const float* ada = (const float*)(F.ws + WS_ADA) + (size_t)(l * 5 + row_modv(r)) * 6144;
    const float* gp = INP(I_GPREMIX) + l * 1024;
    float ss = 0.f;
#pragma unroll
    for (int j = 0; j < 4; ++j) ss += (xv[j].x * xv[j].x + xv[j].y * xv[j].y) + (xv[j].z * xv[j].z + xv[j].w * xv[j].w);
    const float rstd = rsqrtf(wave_sum(ss) * (1.f / 1024.f) + EPS);
    f32x4 h[4];
    bf16* HX = (bf16*)(F.ws + WS_A) + (size_t)r * 1024;
#pragma unroll
    for (int j = 0; j < 4; ++j) { const int c = 4 * F.lane + 256 * j;
        const f32x4 g = *(const f32x4*)(gp + c), sh = *(const f32x4*)(ada + c), scl = *(const f32x4*)(ada + 1024 + c);
        h[j] = (xv[j] * rstd * g) * (scl + 1.0f) + sh;
        v2u o; o.x = pk2(h[j].x, h[j].y); o.y = pk2(h[j].z, h[j].w); *(v2u*)(HX + c) = o; }
    const LAS float* wdt = (const LAS float*)F.lds;
    float acc[16];
#pragma unroll
    for (int q = 0; q < 16; ++q) acc[q] = 0.f;
#pragma unroll
    for (int j = 0; j < 4; ++j) {
#pragma unroll
        for (int i = 0; i < 4; ++i) { const int k = 4 * F.lane + 256 * j + i; const float hv = h[j][i];
#pragma unroll
            for (int q4 = 0; q4 < 4; ++q4) { const f32x4 w = *(const LAS f32x4*)(wdt + k * 16 + (k >> 2) * 4 + 4 * q4);
                acc[4 * q4 + 0] += hv * w.x; acc[4 * q4 + 1] += hv * w.y; acc[4 * q4 + 2] += hv * w.z; acc[4 * q4 + 3] += hv * w.w; }
            asm volatile("" ::: "memory"); }
    }
    float mine = 0.f;
#pragma unroll
    for (int q = 0; q < 16; ++q) { const float s = wave_sum(acc[q]); if (F.lane == q) mine = s; }
    if (F.lane < 16) ((float*)(F.ws + WS_DT))[(size_t)r * 16 + F.lane] = softplusf_(mine + INP(I_DTBIAS)[l * 16 + F.lane]);
}
__device__ __forceinline__ void p1_norm1_first(Frame& F) {
    stage_wdt(F, 0);
    const int gw = F.vcu * NWAVES + F.wave, NGW = F.G * NWAVES;
    for (int r = gw; r < RT; r += NGW) {
        const float* xr = r < RC ? INP(I_CTX) + (size_t)r * 1024 : INP(I_X) + (size_t)(r - RC) * 1024;
        f32x4 xv[4];
#pragma unroll
        for (int j = 0; j < 4; ++j) xv[j] = *(const f32x4*)(xr + 4 * F.lane + 256 * j);
        norm1_row(F, 0, r, xv);
    }
}
__device__ __forceinline__ void rms_row(const f32x4 (&xv)[4], const float* g, int lane, f32x4 (&o)[4]) {
    float ss = 0.f;
#pragma unroll
    for (int j = 0; j < 4; ++j) ss += (xv[j].x * xv[j].x + xv[j].y * xv[j].y) + (xv[j].z * xv[j].z + xv[j].w * xv[j].w);
    const float rstd = rsqrtf(wave_sum(ss) * (1.f / 1024.f) + EPS);
#pragma unroll
    for (int j = 0; j < 4; ++j) o[j] = xv[j] * rstd * *(const f32x4*)(g + 4 * lane + 256 * j);
}
__device__ __forceinline__ const float* xsrc_row(Frame& F, int l, bool after_mix, int r) {
    if (l == 0 && !after_mix) return r < RC ? INP(I_CTX) + (size_t)r * 1024 : INP(I_X) + (size_t)(r - RC) * 1024;
    return r < RC ? (const float*)(F.ws + WS_CTXX) + (size_t)r * 1024 : F.out + (size_t)(r - RC) * 1024;
}
__device__ __forceinline__ float* xdst_row(Frame& F, int r) { return r < RC ? (float*)(F.ws + WS_CTXX) + (size_t)r * 1024 : F.out + (size_t)(r - RC) * 1024; }
__device__ __forceinline__ void p8_postmix(Frame& F, int l, int r_lo) {
    const int gw = F.vcu * NWAVES + F.wave, NGW = F.G * NWAVES;
    bf16* HX2 = (bf16*)(F.ws + WS_A);
    if (r_lo == 0) {
        for (int a = gw; a < 1280; a += NGW) { const int w = a % 320, blk = w >> 6, i = w & 63, tok = 62 * blk - 1 + i;
            if (tok < 0 || tok >= 256) { v4u z = {0u, 0u, 0u, 0u}; *(v4u*)(HX2 + (size_t)a * 1024 + 8 * F.lane) = z; *(v4u*)(HX2 + (size_t)a * 1024 + 512 + 8 * F.lane) = z; } }
    }
    for (int r = r_lo + gw; r < RT; r += NGW) {
        const float* ada = (const float*)(F.ws + WS_ADA) + (size_t)(l * 5 + row_modv(r)) * 6144;
        const float* xm = (const float*)(F.ws + WS_ZXU) + (size_t)r * 1024;
        const float* xr = xsrc_row(F, l, false, r);
        f32x4 mv[4], xv[4], nm[4];
#pragma unroll
        for (int j = 0; j < 4; ++j) { mv[j] = *(const f32x4*)(xm + 4 * F.lane + 256 * j); xv[j] = *(const f32x4*)(xr + 4 * F.lane + 256 * j); }
        rms_row(mv, INP(I_GPOSTMIX) + l * 1024, F.lane, nm);
        float* xo = xdst_row(F, r);
#pragma unroll
        for (int j = 0; j < 4; ++j) { const int c = 4 * F.lane + 256 * j; xv[j] = xv[j] + *(const f32x4*)(ada + 2 * 1024 + c) * nm[j]; *(f32x4*)(xo + c) = xv[j]; }
        rms_row(xv, INP(I_GPREFFN) + l * 1024, F.lane, nm);
        v2u o[4];
#pragma unroll
        for (int j = 0; j < 4; ++j) { const int c = 4 * F.lane + 256 * j; const f32x4 h = nm[j] * (*(const f32x4*)(ada + 4 * 1024 + c) + 1.0f) + *(const f32x4*)(ada + 3 * 1024 + c);
            o[j].x = pk2(h.x, h.y); o[j].y = pk2(h.z, h.w); }
        if (r >= RC) {
#pragma unroll
            for (int j = 0; j < 4; ++j) *(v2u*)(HX2 + (size_t)(1280 + r - RC) * 1024 + 4 * F.lane + 256 * j) = o[j];
        } else {
            const int b = r >> 8, t = r & 255;
            const int blk1 = t / 62;
            { const int a = b * 320 + blk1 * 64 + (t + 1 - 62 * blk1);
#pragma unroll
              for (int j = 0; j < 4; ++j) *(v2u*)(HX2 + (size_t)a * 1024 + 4 * F.lane + 256 * j) = o[j]; }
            const int i1 = t + 1 - 62 * blk1;
            if (i1 == 1 && blk1 > 0) { const int a = b * 320 + (blk1 - 1) * 64 + 63;
#pragma unroll
              for (int j = 0; j < 4; ++j) *(v2u*)(HX2 + (size_t)a * 1024 + 4 * F.lane + 256 * j) = o[j]; }
            if (i1 == 62 && blk1 < 4) { const int a = b * 320 + (blk1 + 1) * 64 + 0;
#pragma unroll
              for (int j = 0; j < 4; ++j) *(v2u*)(HX2 + (size_t)a * 1024 + 4 * F.lane + 256 * j) = o[j]; }
        }
    }
}
__device__ __forceinline__ void p11_postffn(Frame& F, int l, int r_lo) {
    if (l == 0) stage_wdt(F, 1);
    const int gw = F.vcu * NWAVES + F.wave, NGW = F.G * NWAVES;
    for (int r = r_lo + gw; r < RT; r += NGW) {
        const float* ada = (const float*)(F.ws + WS_ADA) + (size_t)(l * 5 + row_modv(r)) * 6144;
        const float* fo = (const float*)(F.ws + WS_FOUT) + (size_t)r * 1024;
        const float* xr = xsrc_row(F, l, true, r);
        f32x4 mv[4], xv[4], nm[4];
#pragma unroll
        for (int j = 0; j < 4; ++j) { mv[j] = *(const f32x4*)(fo + 4 * F.lane + 256 * j); xv[j] = *(const f32x4*)(xr + 4 * F.lane + 256 * j); }
        rms_row(mv, INP(I_GPOSTFFN) + l * 1024, F.lane, nm);
        float* xo = xdst_row(F, r);
#pragma unroll
        for (int j = 0; j < 4; ++j) { const int c = 4 * F.lane + 256 * j; xv[j] = xv[j] + *(const f32x4*)(ada + 5 * 1024 + c) * nm[j]; *(f32x4*)(xo + c) = xv[j]; }
        if (l == 0) norm1_row(F, 1, r, xv);
    }
}
__device__ __forceinline__ f32x4 mfma16(bf16x8 a, bf16x8 b, f32x4 c) { return __builtin_amdgcn_mfma_f32_16x16x32_bf16(a, b, c, 0, 0, 0); }
constexpr float LOG2E = 1.4426950408889634f;
struct ChunkInfo { int r0, b, slot; bool hp, hn; };
__device__ __forceinline__ ChunkInfo chunk_info(int cidx) {
    ChunkInfo c; c.r0 = cidx * 128;
    if (cidx < 8) { c.b = cidx >> 1; const int cp = cidx & 1; c.slot = cp; c.hp = cp > 0; c.hn = cp < 1; }
    else { const int k = cidx - 8; c.b = k >> 5; const int cp = k & 31; c.slot = 2 + cp; c.hp = cp > 0; c.hn = cp < 31; }
    return c;
}
template <int NCOLS, bool TR>
__device__ __forceinline__ void load_conv_tile(Frame& F, int l, int r0, bool hp, bool hn, int c0, LAS bf16* dst, int ld) {
    const bf16* Z = (const bf16*)(F.ws + WS_ZXU);
    const float* cw = INP(I_SCONVW) + l * 3 * 1024; const float* cb = INP(I_SCONVB) + l * 1024;
    constexpr int CG = NCOLS / 8, NBLK = 16 * CG;
    for (int it = F.tid; it < NBLK; it += NTHR) {
        const int rb = it / CG, cg = it % CG, j0 = 8 * rb, ch = c0 + 8 * cg;
        const bf16* p = Z + (size_t)(r0 + j0) * 2048 + 512 + ch;
        v4u raw[10];
        const v4u z4 = {0u, 0u, 0u, 0u};
#pragma unroll
        for (int r = 0; r < 10; ++r) { const int row = j0 - 1 + r; const bool ok = (row >= 0 || hp) && (row < 128 || hn); raw[r] = ok ? *(const v4u*)(p + (ptrdiff_t)(r - 1) * 2048) : z4; }
        f32x4 w0[2], w1[2], w2[2], bb[2];
#pragma unroll
        for (int h = 0; h < 2; ++h) { w0[h] = *(const f32x4*)(cw + ch + 4 * h); w1[h] = *(const f32x4*)(cw + 1024 + ch + 4 * h); w2[h] = *(const f32x4*)(cw + 2048 + ch + 4 * h); bb[h] = *(const f32x4*)(cb + ch + 4 * h); }
        v4u wout[8];
#pragma unroll
        for (int r2 = 0; r2 < 4; ++r2) {
            float o[2][8];
#pragma unroll
            for (int rr = 0; rr < 2; ++rr) { const int r = 2 * r2 + rr;
#pragma unroll
                for (int c = 0; c < 8; ++c) {
                    const int wsel = c >> 1; const bool hi = c & 1;
                    const unsigned pw = wsel == 0 ? raw[r].x : (wsel == 1 ? raw[r].y : (wsel == 2 ? raw[r].z : raw[r].w));
                    const unsigned cwd = wsel == 0 ? raw[r + 1].x : (wsel == 1 ? raw[r + 1].y : (wsel == 2 ? raw[r + 1].z : raw[r + 1].w));
                    const unsigned nw = wsel == 0 ? raw[r + 2].x : (wsel == 1 ? raw[r + 2].y : (wsel == 2 ? raw[r + 2].z : raw[r + 2].w));
                    const float pv = hi ? bfhi(pw) : bflo(pw), cv = hi ? bfhi(cwd) : bflo(cwd), nv = hi ? bfhi(nw) : bflo(nw);
                    const int h = c >> 2, k = c & 3;
                    o[rr][c] = siluf_(bb[h][k] + w0[h][k] * pv + w1[h][k] * cv + w2[h][k] * nv);
                } }
            if constexpr (TR) {
#pragma unroll
                for (int c = 0; c < 8; ++c) { const unsigned wd = pk2(o[0][c], o[1][c]); if (r2 == 0) wout[c].x = wd; else if (r2 == 1) wout[c].y = wd; else if (r2 == 2) wout[c].z = wd; else wout[c].w = wd; }
            } else {
#pragma unroll
                for (int rr = 0; rr < 2; ++rr) { v4u w; w.x = pk2(o[rr][0], o[rr][1]); w.y = pk2(o[rr][2], o[rr][3]); w.z = pk2(o[rr][4], o[rr][5]); w.w = pk2(o[rr][6], o[rr][7]); wout[2 * r2 + rr] = w; }
            }
        }
        if constexpr (!TR) {
#pragma unroll
            for (int r = 0; r < 8; ++r) *(LAS v4u*)(dst + (j0 + r) * ld + 8 * cg) = wout[r];
        } else {
#pragma unroll
            for (int c = 0; c < 8; ++c) *(LAS v4u*)(dst + (8 * cg + c) * ld + j0) = wout[c];
        }
    }
}
constexpr int XS_LD = 136, BS_LD = 136;
constexpr int L_XS = 0, L_BS = L_XS + 256 * XS_LD * 2, L_CS = L_BS + 128 * BS_LD * 2, L_ARR = L_CS + 128 * BS_LD * 2;
constexpr int L_SSQ = L_ARR + 6 * 2048;
static_assert(L_SSQ + 2048 <= 162816, "SSD LDS map");
__device__ __forceinline__ void ssd_decay_arrays(Frame& F, int l, int r0, int g) {
    LAS float* arr = (LAS float*)(F.lds + L_ARR);
    const float* DT = (const float*)(F.ws + WS_DT);
    const int dir = F.wave >> 2, e = F.wave & 3, L = F.lane;
    const float a = -expf(INP(I_ALOG)[l * 16 + dir * 8 + 4 * g + e]) * LOG2E;
    const float d0 = DT[(size_t)(r0 + 2 * L) * 16 + dir * 8 + 4 * g + e], d1 = DT[(size_t)(r0 + 2 * L + 1) * 16 + dir * 8 + 4 * g + e];
    const float v0 = d0 * a, v1 = d1 * a;
    float sc = v0 + v1;
#pragma unroll
    for (int o = 1; o < 64; o <<= 1) { const float t = __shfl_up(sc, o); if (L >= o) sc += t; }
    const float tot = __shfl(sc, 63);
    float c0, c1;
    if (dir == 0) { c1 = sc; c0 = sc - v1; } else { c0 = tot - (sc - v0 - v1); c1 = tot - (sc - v1); }
    const float ctot = tot;
    LAS float* base = arr + e * 128 + 2 * L;
    *(LAS f32x2*)(base + dir * 512) = (f32x2){c0, c1};
    *(LAS f32x2*)(base + (2 + dir) * 512) = (f32x2){d0, d1};
    *(LAS f32x2*)(base + (4 + dir) * 512) = (f32x2){d0 * exp2f(ctot - c0), d1 * exp2f(ctot - c1)};
    __syncthreads();
}
__device__ __forceinline__ void ssd_states_item(Frame& F, int l, int cidx, int g) {
    const ChunkInfo ci = chunk_info(cidx);
    LAS bf16* xs = (LAS bf16*)(F.lds + L_XS); LAS bf16* Bs = (LAS bf16*)(F.lds + L_BS);
    LAS float* arr = (LAS float*)(F.lds + L_ARR);
    load_conv_tile<256, true>(F, l, ci.r0, ci.hp, ci.hn, 256 * g, xs, XS_LD);
    load_conv_tile<128, true>(F, l, ci.r0, ci.hp, ci.hn, 512 + 128 * g, Bs, BS_LD);
    ssd_decay_arrays(F, l, ci.r0, g);
    const int w = F.wave, lane = F.lane, lr = lane & 15, q = lane >> 4, e = w >> 1;
    bf16* ST = (bf16*)(F.ws + WS_A);
#pragma unroll 1
    for (int dir = 0; dir < 2; ++dir) {
        f32x4 acc[2][8];
#pragma unroll
        for (int rt = 0; rt < 2; ++rt)
#pragma unroll
            for (int nt = 0; nt < 8; ++nt) acc[rt][nt] = (f32x4){0.f, 0.f, 0.f, 0.f};
        const LAS float* wd = arr + (4 + dir) * 512 + e * 128;
#pragma unroll 1
        for (int kt = 0; kt < 4; ++kt) {
            const int j0 = 32 * kt + 8 * q;
            const f32x4 wa = *(const LAS f32x4*)(wd + j0), wb = *(const LAS f32x4*)(wd + j0 + 4);
            bf16x8 af[2];
#pragma unroll
            for (int rt = 0; rt < 2; ++rt) { const v4u xv = *(const LAS v4u*)(xs + (32 * w + 16 * rt + lr) * XS_LD + j0);
                v4u o; o.x = pk2(bflo(xv.x) * wa.x, bfhi(xv.x) * wa.y); o.y = pk2(bflo(xv.y) * wa.z, bfhi(xv.y) * wa.w); o.z = pk2(bflo(xv.z) * wb.x, bfhi(xv.z) * wb.y); o.w = pk2(bflo(xv.w) * wb.z, bfhi(xv.w) * wb.w);
                af[rt] = __builtin_bit_cast(bf16x8, o); }
#pragma unroll
            for (int nt = 0; nt < 8; ++nt) { const bf16x8 bf = *(const LAS bf16x8*)(Bs + (16 * nt + lr) * BS_LD + j0);
                acc[0][nt] = mfma16(bf, af[0], acc[0][nt]); acc[1][nt] = mfma16(bf, af[1], acc[1][nt]); }
        }
        bf16* st = ST + ((((size_t)ci.b * 2 + dir) * NSLOT + ci.slot) * 2 + g) * 32768;
#pragma unroll
        for (int rt = 0; rt < 2; ++rt)
#pragma unroll
            for (int nt = 0; nt < 8; ++nt) { const int row = 32 * w + 16 * rt + lr, col = 16 * nt + 4 * q;
                v2u o; o.x = pk2(acc[rt][nt][0], acc[rt][nt][1]); o.y = pk2(acc[rt][nt][2], acc[rt][nt][3]); *(v2u*)(st + row * 128 + col) = o; }
    }
    if (F.tid < 8) { const int dir = F.tid >> 2, ee = F.tid & 3; const LAS float* c = arr + dir * 512 + ee * 128;
        ((float*)(F.ws + WS_DEC))[((((size_t)ci.b * 2 + dir) * NSLOT + ci.slot) * 2 + g) * 4 + ee] = exp2f(dir == 0 ? c[127] : c[0]); }
    __syncthreads();
}
__device__ __forceinline__ void ssd_out_item(Frame& F, int l, int cidx, int g) {
    const ChunkInfo ci = chunk_info(cidx);
    LAS bf16* xs = (LAS bf16*)(F.lds + L_XS); LAS bf16* Bs = (LAS bf16*)(F.lds + L_BS); LAS bf16* Cs = (LAS bf16*)(F.lds + L_CS);
    LAS float* arr = (LAS float*)(F.lds + L_ARR); LAS float* ssq = (LAS float*)(F.lds + L_SSQ);
    load_conv_tile<256, true>(F, l, ci.r0, ci.hp, ci.hn, 256 * g, xs, XS_LD);
    load_conv_tile<128, false>(F, l, ci.r0, ci.hp, ci.hn, 512 + 128 * g, Bs, BS_LD);
    load_conv_tile<128, false>(F, l, ci.r0, ci.hp, ci.hn, 768 + 128 * g, Cs, BS_LD);
    ssd_decay_arrays(F, l, ci.r0, g);
    const int w = F.wave, lane = F.lane, lr = lane & 15, q = lane >> 4;
    {
        f32x4 cacc[8];
#pragma unroll
        for (int jt = 0; jt < 8; ++jt) cacc[jt] = (f32x4){0.f, 0.f, 0.f, 0.f};
#pragma unroll
        for (int kt = 0; kt < 4; ++kt) {
            const bf16x8 a = *(const LAS bf16x8*)(Cs + (16 * w + lr) * BS_LD + 32 * kt + 8 * q);
#pragma unroll
            for (int jt = 0; jt < 8; ++jt) { const bf16x8 b = *(const LAS bf16x8*)(Bs + (16 * jt + lr) * BS_LD + 32 * kt + 8 * q); cacc[jt] = mfma16(a, b, cacc[jt]); }
        }
        __syncthreads();
#pragma unroll
        for (int jt = 0; jt < 8; ++jt)
#pragma unroll
            for (int rg = 0; rg < 4; ++rg) Bs[(16 * w + 4 * q + rg) * BS_LD + 16 * jt + lr] = (bf16)f2bf(cacc[jt][rg]);
        __syncthreads();
    }
    LAS bf16* cbs = Bs;
    const int e = w >> 1, mh = w & 1, head = 4 * g + e;
    const LAS float* cumf = arr + 0 * 512 + e * 128; const LAS float* crev = arr + 1 * 512 + e * 128; const LAS float* dtf = arr + 2 * 512 + e * 128; const LAS float* dtb = arr + 3 * 512 + e * 128;
    f32x4 acc[4][4];
#pragma unroll
    for (int mt = 0; mt < 4; ++mt)
#pragma unroll
        for (int pt = 0; pt < 4; ++pt) acc[mt][pt] = (f32x4){0.f, 0.f, 0.f, 0.f};
    const bf16* ST = (const bf16*)(F.ws + WS_A);
    const bf16* Hf = ST + ((((size_t)ci.b * 2 + 0) * NSLOT + ci.slot) * 2 + g) * 32768 + (size_t)(64 * e) * 128;
    const bf16* Hb = ST + ((((size_t)ci.b * 2 + 1) * NSLOT + ci.slot) * 2 + g) * 32768 + (size_t)(64 * e) * 128;
    bf16x8 hnx[4];
#pragma unroll
    for (int pt = 0; pt < 4; ++pt) hnx[pt] = *(const bf16x8*)(Hf + (size_t)(16 * pt + lr) * 128 + 8 * q);
#pragma unroll 1
    for (int kt = 0; kt < 4; ++kt) {
        const int j0 = 32 * kt + 8 * q;
        bf16x8 bx[4];
#pragma unroll
        for (int pt = 0; pt < 4; ++pt) bx[pt] = *(const LAS bf16x8*)(xs + (64 * e + 16 * pt + lr) * XS_LD + j0);
        float cfj[8], crj[8], dfj[8], dbj[8];
#pragma unroll
        for (int h2 = 0; h2 < 2; ++h2) { const f32x4 a0 = *(const LAS f32x4*)(cumf + j0 + 4 * h2), a1 = *(const LAS f32x4*)(crev + j0 + 4 * h2), a2 = *(const LAS f32x4*)(dtf + j0 + 4 * h2), a3 = *(const LAS f32x4*)(dtb + j0 + 4 * h2);
#pragma unroll
            for (int k = 0; k < 4; ++k) { cfj[4 * h2 + k] = a0[k]; crj[4 * h2 + k] = a1[k]; dfj[4 * h2 + k] = a2[k]; dbj[4 * h2 + k] = a3[k]; } }
#pragma unroll
        for (int mt = 0; mt < 4; ++mt) {
            const int i = 16 * (4 * mh + mt) + lr;
            const float cfi = cumf[i], cri = crev[i];
            const bf16x8 cbv = *(const LAS bf16x8*)(cbs + i * BS_LD + j0);
            bf16x8 a;
#pragma unroll
            for (int jj = 0; jj < 8; ++jj) { const int j = j0 + jj;
                float Lw;
                if (j < i) Lw = exp2f(cfi - cfj[jj]) * dfj[jj];
                else if (j > i) Lw = exp2f(cri - crj[jj]) * dbj[jj];
                else Lw = dfj[jj] + dbj[jj];
                a[jj] = (short)f2bf(bf2f((unsigned short)cbv[jj]) * Lw); }
#pragma unroll
            for (int pt = 0; pt < 4; ++pt) acc[mt][pt] = mfma16(bx[pt], a, acc[mt][pt]);
        }
    }
#pragma unroll 1
    for (int step = 0; step < 8; ++step) {
        const int dir = step >> 2, kt = step & 3;
        bf16x8 bh[4];
#pragma unroll
        for (int pt = 0; pt < 4; ++pt) bh[pt] = hnx[pt];
        if (step + 1 < 8) { const int d2 = (step + 1) >> 2, k2 = (step + 1) & 3; const bf16* H2 = d2 == 0 ? Hf : Hb;
#pragma unroll
            for (int pt = 0; pt < 4; ++pt) hnx[pt] = *(const bf16x8*)(H2 + (size_t)(16 * pt + lr) * 128 + 32 * k2 + 8 * q); }
        const LAS float* cc = dir == 0 ? cumf : crev;
#pragma unroll
        for (int mt = 0; mt < 4; ++mt) {
            const int i = 16 * (4 * mh + mt) + lr;
            const float sc = exp2f(cc[i]);
            const v4u cv = *(const LAS v4u*)(Cs + i * BS_LD + 32 * kt + 8 * q);
            v4u o; o.x = pk2(bflo(cv.x) * sc, bfhi(cv.x) * sc); o.y = pk2(bflo(cv.y) * sc, bfhi(cv.y) * sc); o.z = pk2(bflo(cv.z) * sc, bfhi(cv.z) * sc); o.w = pk2(bflo(cv.w) * sc, bfhi(cv.w) * sc);
            const bf16x8 a = __builtin_bit_cast(bf16x8, o);
#pragma unroll
            for (int pt = 0; pt < 4; ++pt) acc[mt][pt] = mfma16(bh[pt], a, acc[mt][pt]);
        }
    }
    const float Dh = INP(I_SSDD)[l * 8 + head];
    const bf16* Z = (const bf16*)(F.ws + WS_ZXU); bf16* MIX = (bf16*)(F.ws + WS_MIX);
#pragma unroll
    for (int mt = 0; mt < 4; ++mt) {
        const int i = 16 * (4 * mh + mt) + lr;
        float s2 = 0.f;
#pragma unroll
        for (int pt = 0; pt < 4; ++pt) { const int p0 = 16 * pt + 4 * q, col = 64 * head + p0;
            const v2u zz = *(const v2u*)(Z + (size_t)(ci.r0 + i) * 2048 + col);
            const float z0 = bflo(zz.x), z1 = bfhi(zz.x), z2 = bflo(zz.y), z3 = bfhi(zz.y);
            const float v0 = (acc[mt][pt][0] + Dh * bf2f(xs[(64 * e + p0 + 0) * XS_LD + i])) * siluf_(z0);
            const float v1 = (acc[mt][pt][1] + Dh * bf2f(xs[(64 * e + p0 + 1) * XS_LD + i])) * siluf_(z1);
            const float v2 = (acc[mt][pt][2] + Dh * bf2f(xs[(64 * e + p0 + 2) * XS_LD + i])) * siluf_(z2);
            const float v3 = (acc[mt][pt][3] + Dh * bf2f(xs[(64 * e + p0 + 3) * XS_LD + i])) * siluf_(z3);
            s2 += (v0 * v0 + v1 * v1) + (v2 * v2 + v3 * v3);
            v2u o; o.x = pk2(v0, v1); o.y = pk2(v2, v3); *(v2u*)(MIX + (size_t)(ci.r0 + i) * 1024 + col) = o; }
        s2 += __shfl_xor(s2, 16); s2 += __shfl_xor(s2, 32);
        if (q == 0) ssq[e * 128 + i] = s2;
    }
    __syncthreads();
    if (F.tid < 128) ((float*)(F.ws + WS_SSQ))[(size_t)(ci.r0 + F.tid) * 2 + g] = (ssq[F.tid] + ssq[128 + F.tid]) + (ssq[256 + F.tid] + ssq[384 + F.tid]);
    __syncthreads();
}
template <int DIR>
__device__ __forceinline__ void ssd_scan_lane(bf16* __restrict__ ST, const float* __restrict__ DEC, int b, int g, int ep, int n8) {
    const size_t base = (((size_t)b * 2 + DIR) * NSLOT) * 2 * 32768 + (size_t)g * 32768 + (size_t)ep * 128 + 8 * n8;
    const size_t dbase = (((size_t)b * 2 + DIR) * NSLOT) * 8 + g * 4 + (ep >> 6);
    float h[8];
#pragma unroll
    for (int k = 0; k < 8; ++k) h[k] = 0.f;
#pragma unroll
    for (int half = 0; half < 2; ++half) {
        v4u s[17]; float d[17];
#pragma unroll
        for (int k = 0; k < 17; ++k) { const int kk = 17 * half + k; const int slot = DIR == 0 ? kk : (kk == 0 ? 1 : (kk == 1 ? 0 : NSLOT + 1 - kk));
            s[k] = *(const v4u*)(ST + base + (size_t)slot * 65536); d[k] = DEC[dbase + slot * 8]; }
#pragma unroll
        for (int k = 0; k < 17; ++k) { const int kk = 17 * half + k; const int slot = DIR == 0 ? kk : (kk == 0 ? 1 : (kk == 1 ? 0 : NSLOT + 1 - kk));
            v4u o; o.x = pk2(h[0], h[1]); o.y = pk2(h[2], h[3]); o.z = pk2(h[4], h[5]); o.w = pk2(h[6], h[7]);
            *(v4u*)(ST + base + (size_t)slot * 65536) = o;
            h[0] = h[0] * d[k] + bflo(s[k].x); h[1] = h[1] * d[k] + bfhi(s[k].x); h[2] = h[2] * d[k] + bflo(s[k].y); h[3] = h[3] * d[k] + bfhi(s[k].y);
            h[4] = h[4] * d[k] + bflo(s[k].z); h[5] = h[5] * d[k] + bfhi(s[k].z); h[6] = h[6] * d[k] + bflo(s[k].w); h[7] = h[7] * d[k] + bfhi(s[k].w); }
    }
}
__device__ __forceinline__ void p4_scans(Frame& F, int l) {
    bf16* ST = (bf16*)(F.ws + WS_A); const float* DEC = (const float*)(F.ws + WS_DEC);
    const int gt = F.vcu * NTHR + F.tid, GT = F.G * NTHR;
    for (int idx = gt; idx < 4 * 2 * 2 * 256 * 16; idx += GT) {
        const int n8 = idx & 15, ep = (idx >> 4) & 255, g = (idx >> 12) & 1, dir = (idx >> 13) & 1, b = idx >> 14;
        if (dir == 0) ssd_scan_lane<0>(ST, DEC, b, g, ep, n8); else ssd_scan_lane<1>(ST, DEC, b, g, ep, n8);
    }
    f32x2* S5 = (f32x2*)(F.ws + WS_S5ST); const f32x2* LAMQ = (const f32x2*)(F.ws + WS_LAMQ);
    for (int idx = gt; idx < 4 * 2 * 2048; idx += GT) {
        const int gp = idx & 2047, dir = (idx >> 11) & 1, b = idx >> 12;
        const f32x2 lq = LAMQ[(l * 2 + dir) * 2048 + gp];
        f32x2* base = S5 + (((size_t)b * 2 + dir) * NSLOT5) * 2048 + gp;
        f32x2 h = {0.f, 0.f};
#pragma unroll 1
        for (int part = 0; part < NSLOT5 / 17; ++part) {
            f32x2 s[17];
#pragma unroll
            for (int k = 0; k < 17; ++k) { const int kk = 17 * part + k; const int slot = dir == 0 ? kk : (kk < S5NC ? S5NC - 1 - kk : NSLOT5 + S5NC - 1 - kk); s[k] = base[(size_t)slot * 2048]; }
#pragma unroll
            for (int k = 0; k < 17; ++k) { const int kk = 17 * part + k; const int slot = dir == 0 ? kk : (kk < S5NC ? S5NC - 1 - kk : NSLOT5 + S5NC - 1 - kk);
                base[(size_t)slot * 2048] = h; h = (f32x2){lq.x * h.x - lq.y * h.y + s[k].x, lq.x * h.y + lq.y * h.x + s[k].y}; }
        }
    }
}
__device__ __forceinline__ int s5_row0(int b, int n) { return n < S5NC ? b * 256 + S5L * n : RC + b * 4096 + S5L * (n - S5NC); }
__device__ __forceinline__ float gelu_tanh(float x) { const float u = 0.7978845608028654f * (x + 0.044715f * x * x * x); return 0.5f * x * (1.0f + tanhf(u)); }
constexpr int S5_UNITS = (NB * NSLOT5 / 16) * 32;
__device__ __forceinline__ unsigned cvtpk(float lo, float hi) { unsigned r; asm volatile("v_cvt_pk_bf16_f32 %0, %1, %2" : "=v"(r) : "v"(lo), "v"(hi)); return r; }
__device__ __forceinline__ float gelu_fast(float x) {
    const float u2 = 1.5957691216057308f * (x + 0.044715f * x * x * x);
    return x * __builtin_amdgcn_rcpf(1.0f + __expf(-u2));
}
template <bool OUT>
__device__ __forceinline__ void s5_unit(Frame& F, int l, int unit, bool last, LAS unsigned char* wl) {
    const int g = unit & 31, cg = unit >> 5;
    const int lr = F.lane & 15, q = F.lane >> 4;
    const int c16 = 16 * cg + lr, b = c16 / NSLOT5, n64 = c16 - b * NSLOT5;
    const int r0 = s5_row0(b, n64);
    const bool skip_out = last && n64 < S5NC;
    const bf16* zrow = (const bf16*)(F.ws + WS_ZXU) + (size_t)r0 * 2048 + 1536 + 16 * g;
    f32x2* S5 = (f32x2*)(F.ws + WS_S5ST);
    LAS v2u* ypl = (LAS v2u*)(wl + 4096) + F.lane;
    bf16* GO = (bf16*)(F.ws + WS_G) + (size_t)r0 * 512 + 16 * g + 4 * q;
    LAS bf16x8* cml = (LAS bf16x8*)wl + F.lane;
    f32x4 dsk = {0.f, 0.f, 0.f, 0.f};
    if constexpr (OUT) {
        const bf16* CM = (const bf16*)(F.ws + WS_CMAT) + ((size_t)(l * 32 + g) * 16 + lr) * 128;
#pragma unroll
        for (int kt = 0; kt < 4; ++kt) { const v2u lo = *(const v2u*)(CM + 32 * kt + 4 * q), hi = *(const v2u*)(CM + 32 * kt + 16 + 4 * q);
            v4u w = {lo.x, lo.y, hi.x, hi.y}; cml[kt * 64] = __builtin_bit_cast(bf16x8, w); }
        dsk = *(const f32x4*)(INP(I_S5D) + l * 512 + 16 * g + 4 * q);
        LDS_WAIT(); asm volatile("" ::: "memory");
    }
#pragma unroll 1
    for (int dir = 0; dir < 2; ++dir) {
        const int ldg = (l * 2 + dir) * 32 + g;
        const bf16* BBT = (const bf16*)(F.ws + WS_BBAR) + (size_t)ldg * 128 * 16;
        bf16x8 bfr[8]; f32x4 lam[8], h[8];
#pragma unroll
        for (int tl = 0; tl < 8; ++tl) { const bf16x8 v = *(const bf16x8*)(BBT + (16 * tl + lr) * 16 + 8 * (q & 1));
#pragma unroll
            for (int j = 0; j < 8; ++j) bfr[tl][j] = q < 2 ? v[j] : (short)0;
            lam[tl] = *(const f32x4*)((const float*)(F.ws + WS_LAMB) + ((size_t)ldg * 64 + 8 * tl + 2 * q) * 2);
            if constexpr (OUT) h[tl] = *(const f32x4*)((const float*)(S5 + (((size_t)b * 2 + dir) * NSLOT5 + n64) * 2048 + g * 64 + 8 * tl + 2 * q));
            else h[tl] = (f32x4){0.f, 0.f, 0.f, 0.f}; }
        bf16x8 uA, uB; v2u pA = {0u, 0u}, pB = pA, vA = pA, vB = pA;
#define S5_LOADTOK(kidx, UQ, PQ, VQ) do { const int tt_ = dir == 0 ? (kidx) : S5L - 1 - (kidx); UQ = *(const bf16x8*)(zrow + (size_t)tt_ * 2048 + 8 * (q & 1)); \
            if constexpr (OUT) { if (dir == 1) { VQ = *(const v2u*)(zrow + (size_t)tt_ * 2048 + 4 * q); } } } while (0)
#define S5_TOKEN(kidx, UQ, PQ, VQ, PF) do { \
            const int tt = dir == 0 ? (kidx) : S5L - 1 - (kidx); \
            bf16x8 ub; _Pragma("unroll") for (int j = 0; j < 8; ++j) ub[j] = q < 2 ? UQ[j] : (short)0; \
            const v2u u4 = VQ; \
            if (PF > 0 && (kidx) + PF < S5L) S5_LOADTOK((kidx) + PF, UQ, PQ, VQ); \
            _Pragma("unroll") for (int tl = 0; tl < 8; ++tl) { \
                const f32x4 d = mfma16(bfr[tl], ub, (f32x4){0.f, 0.f, 0.f, 0.f}); \
                const f32x4 hh = h[tl], lm = lam[tl]; \
                h[tl] = (f32x4){lm.x * hh.x - lm.y * hh.y + d.x, lm.x * hh.y + lm.y * hh.x + d.y, lm.z * hh.z - lm.w * hh.w + d.z, lm.z * hh.w + lm.w * hh.z + d.w}; } \
            if constexpr (OUT) { \
                bf16x8 ca[4]; _Pragma("unroll") for (int kt = 0; kt < 4; ++kt) ca[kt] = cml[kt * 64]; \
                f32x4 y = {0.f, 0.f, 0.f, 0.f}; \
                _Pragma("unroll") for (int kt = 0; kt < 4; ++kt) { const f32x4 a0 = h[2 * kt], a1 = h[2 * kt + 1]; \
                    v4u w; w.x = cvtpk(a0.x, a0.y); w.y = cvtpk(a0.z, a0.w); w.z = cvtpk(a1.x, a1.y); w.w = cvtpk(a1.z, a1.w); \
                    y = mfma16(ca[kt], __builtin_bit_cast(bf16x8, w), y); } \
                if (dir == 0) { v2u o; o.x = cvtpk(y.x, y.y); o.y = cvtpk(y.z, y.w); ypl[tt * 64] = o; } \
                else { const v2u pf = ypl[tt * 64]; \
                    const float y0 = y.x + bflo(pf.x) + dsk.x * bflo(u4.x), y1 = y.y + bfhi(pf.x) + dsk.y * bfhi(u4.x), y2 = y.z + bflo(pf.y) + dsk.z * bflo(u4.y), y3 = y.w + bfhi(pf.y) + dsk.w * bfhi(u4.y); \
                    v2u o; o.x = cvtpk(gelu_fast(y0), gelu_fast(y1)); o.y = cvtpk(gelu_fast(y2), gelu_fast(y3)); \
                    ypl[tt * 64] = o; } \
            } __builtin_amdgcn_sched_barrier(0); } while (0)
        S5_LOADTOK(0, uA, pA, vA);
        if constexpr (OUT) {
#pragma unroll 1
            for (int k = 0; k < S5L; ++k) {
                asm volatile("" ::: "memory");
                if (k + 1 < S5L) S5_LOADTOK(k + 1, uB, pB, vB);
                S5_TOKEN(k, uA, pA, vA, 0);
                uA = uB; pA = pB; vA = vB;
            }
        } else {
            bf16x8 uC, uD; v2u pC = pA, pD = pA, vC = pA, vD = pA;
            S5_LOADTOK(1, uB, pB, vB); S5_LOADTOK(2, uC, pC, vC); S5_LOADTOK(3, uD, pD, vD);
#pragma unroll 1
            for (int k = 0; k < S5L; k += 4) { S5_TOKEN(k, uA, pA, vA, 4); S5_TOKEN(k + 1, uB, pB, vB, 4); S5_TOKEN(k + 2, uC, pC, vC, 4); S5_TOKEN(k + 3, uD, pD, vD, 4); }
        }
#undef S5_TOKEN
#undef S5_LOADTOK
        if constexpr (OUT) { if (dir == 1 && !skip_out) { LDS_WAIT();
#pragma unroll 8
            for (int tt = 0; tt < S5L; ++tt) *(v2u*)(GO + (size_t)tt * 512) = ypl[tt * 64]; } }
        if constexpr (!OUT) {
#pragma unroll
            for (int tl = 0; tl < 8; ++tl) *(f32x4*)((float*)(S5 + (((size_t)b * 2 + dir) * NSLOT5 + n64) * 2048 + g * 64 + 8 * tl + 2 * q)) = h[tl];
        }
    }
}
__device__ __forceinline__ void rescale_ssd_rows(Frame& F, int l, int r_lo) {
    const int gw = F.vcu * NWAVES + F.wave, NGW = F.G * NWAVES;
    const float* SSQ = (const float*)(F.ws + WS_SSQ); bf16* MIX = (bf16*)(F.ws + WS_MIX);
    const float* ng = INP(I_SNORMG) + l * 512 + 8 * F.lane;
    const f32x4 g0 = *(const f32x4*)ng, g1 = *(const f32x4*)(ng + 4);
    for (int r = r_lo + gw; r < RT; r += NGW) {
        const float sc = rsqrtf((SSQ[(size_t)r * 2] + SSQ[(size_t)r * 2 + 1]) * (1.f / 512.f) + EPS);
        v4u v = *(const v4u*)(MIX + (size_t)r * 1024 + 8 * F.lane);
        v.x = pk2(bflo(v.x) * sc * g0.x, bfhi(v.x) * sc * g0.y); v.y = pk2(bflo(v.y) * sc * g0.z, bfhi(v.y) * sc * g0.w);
        v.z = pk2(bflo(v.z) * sc * g1.x, bfhi(v.z) * sc * g1.y); v.w = pk2(bflo(v.w) * sc * g1.z, bfhi(v.w) * sc * g1.w);
        *(v4u*)(MIX + (size_t)r * 1024 + 8 * F.lane) = v;
    }
}
#ifndef PH_MASK
#define PH_MASK 0xFFFF
#endif
#ifndef DUP_MASK
#define DUP_MASK 0
#endif
#define PH(k) for (int rep_ = 0; rep_ < ((((PH_MASK) >> (k)) & 1) ? 1 + (((DUP_MASK) >> (k)) & 1) : 0); ++rep_)
#define LAUNDER() do { unsigned long long w_ = F.ptab[N_IN + 1], o_ = F.ptab[N_IN]; w_ = ((unsigned long long)(unsigned)__builtin_amdgcn_readfirstlane((int)(w_ >> 32)) << 32) | (unsigned)__builtin_amdgcn_readfirstlane((int)w_); o_ = ((unsigned long long)(unsigned)__builtin_amdgcn_readfirstlane((int)(o_ >> 32)) << 32) | (unsigned)__builtin_amdgcn_readfirstlane((int)o_); F.ws = (unsigned char*)(GAS unsigned char*)w_; F.out = (float*)(GAS float*)o_; F.ctl = (gu32*)(F.ws + WS_CTL); int t_ = threadIdx.x; asm volatile("" : "+v"(t_)); F.tid = t_; F.lane = t_ & 63; F.wave = __builtin_amdgcn_readfirstlane(t_ >> 6); F.G = gridDim.x; { const int bx = blockIdx.x; F.vcu = (F.G % 8 == 0) ? (bx % 8) * (F.G / 8) + bx / 8 : bx; } } while (0)
struct Args { const float* in[N_IN]; float* out; unsigned char* ws; };
__global__ void __launch_bounds__(NTHR, 2) mega_fwd(Args args) {
    extern __shared__ __attribute__((aligned(16))) unsigned char lds[];
    Frame F;
    F.lds = (LAS unsigned char*)lds;
    F.MISC = (volatile LAS unsigned*)(F.lds + MISC_OFF);
    F.tid = threadIdx.x; F.lane = F.tid & 63; F.wave = __builtin_amdgcn_readfirstlane(F.tid >> 6);
    F.G = gridDim.x; { const int bx = blockIdx.x; F.vcu = (F.G % 8 == 0) ? (bx % 8) * (F.G / 8) + bx / 8 : bx; }
    F.out = args.out; F.ws = args.ws;
    F.ctl = (gu32*)(F.ws + WS_CTL);
    for (int u = F.tid; u < (LDS_BYTES - LDSCTL_OFF) / 4; u += NTHR) ((LAS unsigned*)(F.lds + LDSCTL_OFF))[u] = 0u;
    __syncthreads();
    if (F.tid < N_IN) ((LAS unsigned long long*)(F.lds + PTAB_OFF))[F.tid] = (unsigned long long)args.in[F.tid];
    if (F.tid == N_IN) ((LAS unsigned long long*)(F.lds + PTAB_OFF))[N_IN] = (unsigned long long)args.out;
    if (F.tid == N_IN + 1) ((LAS unsigned long long*)(F.lds + PTAB_OFF))[N_IN + 1] = (unsigned long long)args.ws;
    F.ptab = (const LAS unsigned long long*)(F.lds + PTAB_OFF);
    __syncthreads();
    (void)xcd_barrier_post((unsigned*)(F.ctl + CW_BAR), F.MISC + 8);
#define GRID_BAR() do { XcdBarrier bar_; bar_.bar = (unsigned*)(F.ctl + CW_BAR); bar_.x = xb_xcc_id(); bar_.st = (volatile LAS unsigned*)(F.lds + MISC_OFF) + 8; xcd_barrier(bar_); LAUNDER(); } while (0)

    PH(0) { p0_ada_tables(F); LAUNDER(); convert_weights(F, 0, 32768); }
    GRID_BAR();
    PH(1) p1_norm1_first(F);
    GRID_BAR();

#pragma unroll 1
    for (int l = 0; l < DEPTH; ++l) {
        const bool last = (l == DEPTH - 1);
        const int r_lo = last ? RC : 0;
        const int t_lo = r_lo / 256, Mrows = RT - r_lo;
        PH(2) {
            pg8::Gemm g{(const bf16*)(F.ws + WS_A), (const bf16*)(F.ws + WS_WIN), RT, NZXU, 1024}; pg8::StaticOrder S; S.init(RT, NZXU, F.G, (int)blockIdx.x);
            pg8::EpiStoreBf16 E{(bf16*)(F.ws + WS_ZXU), NZXU};
            pg8::gemm_phase<pg8::EpiStoreBf16, pg8::StaticOrder, true, true>(F.lds, g, S, E, F.tid);
        }
        GRID_BAR();
        PH(3) for (int it = F.vcu; it < 272; it += F.G) ssd_states_item(F, l, it >> 1, it & 1);
        __syncthreads(); LAUNDER();
        PH(12) {
            const int nsk = (272 > F.G && 272 - F.G < F.G) ? 272 - F.G : 0;
            const int gw = F.wave * (F.G - nsk) + (F.vcu - nsk), NGW = (F.G - nsk) * 5;
            if (F.wave < 5 && F.vcu >= nsk) for (int u = gw; u < S5_UNITS; u += NGW) s5_unit<false>(F, l, u, last, F.lds + (F.wave % 5) * 20480);
        }
        GRID_BAR();
        PH(4) p4_scans(F, l);
        GRID_BAR();
        PH(5) for (int it = F.vcu; it < 272; it += F.G) { const int cidx = it >> 1; if (last && cidx < 8) continue; ssd_out_item(F, l, cidx, it & 1); }
        __syncthreads(); LAUNDER();
        PH(13) {
            const int nsk = (272 > F.G && 272 - F.G < F.G) ? 272 - F.G : 0;
            const int gw = F.wave * (F.G - nsk) + (F.vcu - nsk), NGW = (F.G - nsk) * 5;
            if (F.wave < 5 && F.vcu >= nsk) for (int u = gw; u < S5_UNITS; u += NGW) s5_unit<true>(F, l, u, last, F.lds + (F.wave % 5) * 20480);
        }
        GRID_BAR();
        PH(14) rescale_ssd_rows(F, l, r_lo);
        LAUNDER();
        PH(6) {
            const bf16* Gm = (const bf16*)(F.ws + WS_G) + (size_t)r_lo * 512;
            pg8::Gemm g{Gm, (const bf16*)(F.ws + WS_WGLU), Mrows, 512, 512}; pg8::StaticOrder S; S.init(Mrows, 512, F.G, (int)blockIdx.x);
            pg8::EpiGlu E{Gm, (bf16*)(F.ws + WS_MIX) + (size_t)r_lo * 1024 + 512, INP(I_GLUB) + l * 512};
            pg8::gemm_phase<pg8::EpiGlu, pg8::StaticOrder, true, true>(F.lds, g, S, E, F.tid);
        }
        GRID_BAR();
        PH(7) {
            pg8::Gemm g{(const bf16*)(F.ws + WS_MIX) + (size_t)r_lo * 1024, (const bf16*)(F.ws + WS_WOUT), Mrows, 1024, 1024}; pg8::StaticOrder S; S.init(Mrows, 1024, F.G, (int)blockIdx.x);
            pg8::EpiStoreF32 E{(float*)(F.ws + WS_ZXU) + (size_t)r_lo * 1024, 1024};
            pg8::gemm_phase<pg8::EpiStoreF32, pg8::StaticOrder, true, true>(F.lds, g, S, E, F.tid);
        }
        GRID_BAR();
        PH(8) p8_postmix(F, l, r_lo);
        GRID_BAR();
        PH(9) {
            const int tile0 = last ? 5 : 0, Mh = RH - tile0 * 256;
            pg8::Gemm g{(const bf16*)(F.ws + WS_A) + (size_t)tile0 * 256 * 1024, (const bf16*)(F.ws + WS_WUP), Mh, 5632, 1024}; pg8::StaticOrder S; S.init(Mh, 5632, F.G, (int)blockIdx.x);
            pg8::EpiFfnUp E{(bf16*)(F.ws + WS_HACT), INP(I_FCONVW) + (size_t)l * 3 * 5632, INP(I_FCONVB) + (size_t)l * 5632, tile0};
            pg8::gemm_phase<pg8::EpiFfnUp, pg8::StaticOrder, true, true>(F.lds, g, S, E, F.tid);
        }
        GRID_BAR();
        PH(10) {
            pg8::Gemm g{(const bf16*)(F.ws + WS_HACT) + (size_t)r_lo * 2816, (const bf16*)(F.ws + WS_WDOWN), Mrows, 1024, 2816}; pg8::StaticOrder S; S.init(Mrows, 1024, F.G, (int)blockIdx.x);
            pg8::EpiStoreF32 E{(float*)(F.ws + WS_FOUT) + (size_t)r_lo * 1024, 1024};
            pg8::gemm_phase<pg8::EpiStoreF32, pg8::StaticOrder, true, true>(F.lds, g, S, E, F.tid);
        }
        GRID_BAR();
        PH(11) p11_postffn(F, l, r_lo);
        if (!last) { __syncthreads(); LAUNDER(); PH(11) convert_weights(F, l + 1, 73728); GRID_BAR(); }
    }
}

extern "C" void kernel_launch(void* const* d_in, const int* in_sizes, int n_in, void* d_out, int out_size, void* d_ws, size_t ws_size, hipStream_t stream) {
    static int grid = 0;
    if (grid == 0) {
        if (n_in != N_IN || out_size != RL * DM || ws_size < WS_END) { fprintf(stderr, "kernel_launch: unexpected shapes (n_in %d, out %d, ws %zu); nothing launched\n", n_in, out_size, ws_size); grid = -1; return; }
        int dev = 0, cus = 0, per_cu = 0;
        if (hipGetDevice(&dev) != hipSuccess || hipDeviceGetAttribute(&cus, hipDeviceAttributeMultiprocessorCount, dev) != hipSuccess) { grid = -1; return; }
        if (hipFuncSetAttribute((const void*)mega_fwd, hipFuncAttributeMaxDynamicSharedMemorySize, LDS_BYTES) != hipSuccess) { fprintf(stderr, "kernel_launch: hipFuncSetAttribute failed\n"); grid = -1; return; }
        if (hipOccupancyMaxActiveBlocksPerMultiprocessor(&per_cu, (const void*)mega_fwd, NTHR, LDS_BYTES) != hipSuccess || per_cu < 1) { fprintf(stderr, "kernel_launch: occupancy query says %d\n", per_cu); }
        (void)hipGetLastError();
        grid = cus;
    }
    if (grid < 0) return;
    if (hipMemsetAsync((char*)d_ws + WS_CTL, 0, CTL_ZERO_BYTES, stream) != hipSuccess) return;
    Args a{};
    for (int i = 0; i < N_IN; ++i) a.in[i] = (const float*)d_in[i];
    a.out = (float*)d_out; a.ws = (unsigned char*)d_ws;
    hipLaunchKernelGGL(mega_fwd, dim3(grid), dim3(NTHR), LDS_BYTES, stream, a);
}
```
